# Optimizing an MI355X kernel written in HIP

```python
import jax, jax.numpy as jnp
from jax import lax
import numpy as np

D_MODEL = 4096
BATCH = 4
SEQ = 4096
DEPTH = 1

MEM_LEN = 256
MIX_WIDTH = D_MODEL
GROUP_DIM = 128
CONV_WIDTH = MIX_WIDTH // 2
SCONV_WIDTH = MIX_WIDTH - CONV_WIDTH
N_CONV_GROUPS = CONV_WIDTH // GROUP_DIM
N_SCONV_HEADS = SCONV_WIDTH // GROUP_DIM
IN_WIDTH = 2 * CONV_WIDTH + 3 * SCONV_WIDTH
CONV_KERNEL = 31
SHORT_KERNEL = 3
FFN_KERNEL = 3
D_FF = ((8 * D_MODEL // 3 + 255) // 256) * 256
N_XATTN_HEADS = 4
XATTN_HEAD_DIM = D_MODEL // N_XATTN_HEADS
EPS = 1e-6

kernel_name = "hybrid_conformer_shortconv_xattn_convffn"


def rms_norm(x, g):
    xf = x.astype(jnp.float32)
    y = xf * lax.rsqrt(jnp.mean(xf * xf, axis=-1, keepdims=True) + EPS)
    return (y * g.astype(jnp.float32)).astype(x.dtype)


def group_layer_norm(x, g, b, group):
    shape = x.shape
    xf = x.astype(jnp.float32).reshape(*shape[:-1], shape[-1] // group, group)
    mu = jnp.mean(xf, axis=-1, keepdims=True)
    xc = xf - mu
    var = jnp.mean(xc * xc, axis=-1, keepdims=True)
    y = (xc * lax.rsqrt(var + EPS)).reshape(shape)
    return (y * g.astype(jnp.float32) + b.astype(jnp.float32)).astype(x.dtype)


def causal_dwconv(x, w):
    K = w.shape[0]
    T = x.shape[1]
    xp = jnp.pad(x, ((0, 0), (K - 1, 0), (0, 0)))
    y = xp[:, 0:T, :] * w[0]
    for k in range(1, K):
        y = y + xp[:, k:k + T, :] * w[k]
    return y


def setup_inputs(seed: int = 0) -> dict:
    key = jax.random.key(seed)
    ks = jax.random.split(key, 24)

    def nrm(k, shape, scale):
        return jax.random.normal(k, shape, jnp.float32) * scale

    def gain(k, shape):
        return 1.0 + 0.02 * jax.random.normal(k, shape, jnp.float32)

    L = DEPTH
    return {
        "x": nrm(ks[0], (BATCH, SEQ, D_MODEL), 1.0),
        "mem": nrm(ks[1], (BATCH, MEM_LEN, D_MODEL), 1.0),
        "g_mix": gain(ks[2], (L, D_MODEL)),
        "w_in": nrm(ks[3], (L, D_MODEL, IN_WIDTH), D_MODEL ** -0.5),
        "conv_a_w": nrm(ks[4], (L, CONV_KERNEL, CONV_WIDTH), CONV_KERNEL ** -0.5),
        "conv_a_b": nrm(ks[5], (L, CONV_WIDTH), 0.02),
        "ln_a_g": gain(ks[6], (L, CONV_WIDTH)),
        "ln_a_b": nrm(ks[7], (L, CONV_WIDTH), 0.02),
        "conv_b_w": nrm(ks[8], (L, SHORT_KERNEL, SCONV_WIDTH), SHORT_KERNEL ** -0.5),
        "w_out": nrm(ks[9], (L, MIX_WIDTH, D_MODEL), MIX_WIDTH ** -0.5),
        "g_xattn": gain(ks[10], (L, D_MODEL)),
        "g_mem": gain(ks[11], (D_MODEL,)),
        "w_q": nrm(ks[12], (L, D_MODEL, D_MODEL), D_MODEL ** -0.5),
        "w_k": nrm(ks[13], (L, D_MODEL, D_MODEL), D_MODEL ** -0.5),
        "w_v": nrm(ks[14], (L, D_MODEL, D_MODEL), D_MODEL ** -0.5),
        "w_o": nrm(ks[15], (L, D_MODEL, D_MODEL), D_MODEL ** -0.5),
        "g_ffn": gain(ks[16], (L, D_MODEL)),
        "w_gate": nrm(ks[17], (L, D_MODEL, D_FF), D_MODEL ** -0.5),
        "w_up": nrm(ks[18], (L, D_MODEL, D_FF), D_MODEL ** -0.5),
        "conv_f_w": nrm(ks[19], (L, FFN_KERNEL, D_FF), FFN_KERNEL ** -0.5),
        "w_down": nrm(ks[20], (L, D_FF, D_MODEL), D_FF ** -0.5),
        "g_final": gain(ks[21], (D_MODEL,)),
    }


def reference(x, mem, g_mix, w_in, conv_a_w, conv_a_b, ln_a_g, ln_a_b, conv_b_w,
              w_out, g_xattn, g_mem, w_q, w_k, w_v, w_o, g_ffn, w_gate, w_up,
              conv_f_w, w_down, g_final):
    B, T, D = x.shape
    M = mem.shape[1]
    memn = rms_norm(mem, g_mem)
    splits = [CONV_WIDTH, 2 * CONV_WIDTH, 2 * CONV_WIDTH + SCONV_WIDTH,
              2 * CONV_WIDTH + 2 * SCONV_WIDTH]
    h = x
    for l in range(DEPTH):
        xn = rms_norm(h, g_mix[l])
        proj = xn @ w_in[l]
        a_val, a_gate, b_gate, c_gate, b_h = jnp.split(proj, splits, axis=-1)
        u = a_val * jax.nn.sigmoid(a_gate)
        u = causal_dwconv(u, conv_a_w[l]) + conv_a_b[l]
        u = jax.nn.silu(group_layer_norm(u, ln_a_g[l], ln_a_b[l], GROUP_DIM))
        v = b_gate * causal_dwconv(c_gate * b_h, conv_b_w[l])
        mix = jnp.concatenate([u, v], axis=-1)
        h = h + mix @ w_out[l]

        xn = rms_norm(h, g_xattn[l])
        q = (xn @ w_q[l]).reshape(B, T, N_XATTN_HEADS, XATTN_HEAD_DIM)
        k = (memn @ w_k[l]).reshape(B, M, N_XATTN_HEADS, XATTN_HEAD_DIM)
        vm = (memn @ w_v[l]).reshape(B, M, N_XATTN_HEADS, XATTN_HEAD_DIM)
        s = jnp.einsum('bthd,bmhd->bhtm', q.astype(jnp.float32), k.astype(jnp.float32))
        p = jax.nn.softmax(s * (XATTN_HEAD_DIM ** -0.5), axis=-1).astype(vm.dtype)
        o = jnp.einsum('bhtm,bmhd->bthd', p, vm).reshape(B, T, D)
        h = h + o @ w_o[l]

        xn = rms_norm(h, g_ffn[l])
        g = causal_dwconv(xn @ w_gate[l], conv_f_w[l])
        f = jax.nn.silu(g) * (xn @ w_up[l])
        h = h + f @ w_down[l]
    return rms_norm(h, g_final)
```

```cpp
#include <hip/hip_runtime.h>
#include <cstdio>

#ifndef MK_N_LAUNCHES
#define MK_N_LAUNCHES 1
#endif
static_assert(MK_N_LAUNCHES == 1, "phases P1 and P5 contain grid barriers of their own: only the one-launch build is supported");
#ifndef DUP_VAR
#define DUP_VAR 0
#endif
#ifndef DUP_MASK
#define DUP_MASK 0x0
#endif

#define GAS __attribute__((address_space(1)))
#define LAS __attribute__((address_space(3)))
typedef unsigned short bf16;
typedef short bf16x8 __attribute__((ext_vector_type(8)));
typedef float f32x4 __attribute__((ext_vector_type(4)));
typedef float f32x2 __attribute__((ext_vector_type(2)));
typedef unsigned u32x4 __attribute__((ext_vector_type(4)));
typedef unsigned u32x2 __attribute__((ext_vector_type(2)));
typedef int i32x4 __attribute__((ext_vector_type(4)));
typedef GAS unsigned gu32;

constexpr int DM = 4096, NBATCH = 4, SEQ = 4096, MTOK = NBATCH * SEQ, MEMLEN = 256, MMEM = NBATCH * MEMLEN;
constexpr int CWID = 2048;
constexpr int INW = 10240;
constexpr int FF = 11008;
constexpr int NHEAD = 4, HDIM = 1024;
constexpr int CONVK = 31;
constexpr float EPS = 1e-6f;
constexpr float LOG2E = 1.4426950408889634f;

__device__ __forceinline__ unsigned cvt_pk_bf16(float lo, float hi) { unsigned r; asm volatile("v_cvt_pk_bf16_f32 %0, %1, %2" : "=v"(r) : "v"(lo), "v"(hi)); return r; }
__device__ __forceinline__ float bf_lo(unsigned w) { return __uint_as_float(w << 16); }
__device__ __forceinline__ float bf_hi(unsigned w) { return __uint_as_float(w & 0xffff0000u); }
__device__ __forceinline__ float fast_sigmoid(float x) { return __builtin_amdgcn_rcpf(1.0f + __builtin_amdgcn_exp2f(-x * LOG2E)); }
template <int N> __device__ __forceinline__ float dpp_shr(float v) { return __int_as_float(__builtin_amdgcn_update_dpp(0, __float_as_int(v), 0x110 + N, 0xf, 0xf, true)); }
template <int N> __device__ __forceinline__ float dpp_shl(float v) { return __int_as_float(__builtin_amdgcn_update_dpp(0, __float_as_int(v), 0x100 + N, 0xf, 0xf, true)); }
__device__ __forceinline__ float wave_sum(float v) {
#pragma unroll
    for (int o = 1; o < 64; o <<= 1) v += __shfl_xor(v, o);
    return v;
}

namespace pg8 {
constexpr int BM = 256, BK = 64, HALF = 128, HTB = HALF * BK * 2, STAGE_BYTES = 8 * HTB, NXCD = 8, WGM = 8;
__host__ __device__ __forceinline__ int lds_byte(int r, int c) { const int st = (r >> 4) * 2 + (c >> 5), rr = r & 15, cc = c & 31, ob = rr * 64 + cc * 2; return st * 1024 + (ob ^ (((ob >> 9) & 1) << 5)); }
__host__ __device__ __forceinline__ void stage_rc(int b, int& R, int& C) { const int st = b / 1024, sb = b % 1024, swz = sb ^ (((sb >> 9) & 1) << 5); R = (st >> 1) * 16 + swz / 64; C = (st & 1) * 32 + (swz % 64) / 2; }
__host__ __device__ __forceinline__ int perm32(int rho) { const int n = rho >> 4, i = rho & 15; return 8 * (i >> 2) + 4 * n + (i & 3); }

struct Unit { int pm, pn, z; };
struct Gemm { const bf16* A; const bf16* Bt; int lda, ldb, K, zdiv, bdiv; size_t sAhi, sAlo, sBhi, sBlo, sBpm; };
__device__ __forceinline__ const char* unitA(const Gemm& g, const Unit& u) { return (const char*)(g.A + (size_t)(u.z / g.zdiv) * g.sAhi + (size_t)(u.z % g.zdiv) * g.sAlo + (size_t)u.pm * BM * g.lda); }
__device__ __forceinline__ const char* unitB(const Gemm& g, const Unit& u) { return (const char*)(g.Bt + (size_t)(u.z / g.zdiv) * g.sBhi + (size_t)(u.z % g.zdiv) * g.sBlo + (size_t)(u.pm / g.bdiv) * g.sBpm + (size_t)u.pn * BM * g.ldb); }

struct StaticOrder {
    int nM, nN, nwg, G, c;
    __device__ void init(int nM_, int nN_, int G_, int c_) { nM = nM_; nN = nN_; nwg = nM * nN; G = G_; c = c_; }
    __device__ bool next(int i, Unit& u) const {
        const long L = (long)i * G + c; if (L >= nwg) return false;
        int wgid = (int)L; { const int q = nwg / NXCD, r = nwg % NXCD, xcd = wgid % NXCD, off = wgid / NXCD; wgid = (xcd < r ? xcd * (q + 1) : r * (q + 1) + (xcd - r) * q) + off; }
        const int nig = WGM * nN, gid = wgid / nig, fm = gid * WGM, gsz = (nM - fm) < WGM ? (nM - fm) : WGM;
        u.pm = fm + ((wgid % nig) % gsz); u.pn = (wgid % nig) / gsz; u.z = 0; return true;
    }
};
struct BatchOrder {
    int nM, nN, nZ, G, c;
    __device__ void init(int nM_, int nN_, int nZ_, int G_, int c_) { nM = nM_; nN = nN_; nZ = nZ_; G = G_; c = c_; }
    __device__ bool next(int i, Unit& u) const {
        const long L = (long)i * G + c; if (L >= (long)nM * nN * nZ) return false;
        const int per = nM * nN, l = (int)L; u.z = l / per; const int rem = l % per; u.pm = rem / nN; u.pn = rem % nN; return true;
    }
};

template <bool I8 = false, int VAR = 0, class Epi, class Sched>
__device__ __forceinline__ void gemm_phase(LAS unsigned char* lds, LAS unsigned char* scr, const Gemm g, const Sched& S, const Epi& E) {
    const int tid = threadIdx.x, wid = __builtin_amdgcn_readfirstlane(tid >> 6), lane = tid & 63, wr = wid >> 2, wc = wid & 3, fr = lane & 15, fq = lane >> 4;
    const int K = g.K, nt = K / BK;
    unsigned voffA[2], voffB[2];
#pragma unroll
    for (int i = 0; i < 2; ++i) { int R, C; stage_rc(tid * 16 + i * 8192, R, C); const int Rb = Epi::PERM ? ((R & ~31) + perm32(R & 31)) : R;
        voffA[i] = (unsigned)(R * g.lda + C) * 2u; voffB[i] = (unsigned)(Rb * g.ldb + C) * 2u; }
    const size_t kstep = (size_t)(BK * 2);
    const size_t hstepA = (size_t)HALF * g.lda * 2, hstepB = (size_t)HALF * g.ldb * 2;
    const unsigned ldsw = (unsigned)wid * 1024u;
    const int aoff = lds_byte(wr * 64 + fr, fq * 8), boff = lds_byte(wc * 32 + fr, fq * 8);
#define PG8_SA(b, h) (((b) * 2 + (h)) * HTB)
#define PG8_SB(b, h) ((4 + (b) * 2 + (h)) * HTB)
#define PG8_STAGE(bufoff, gbase, voff) do { if constexpr (VAR != 1 && VAR != 3) { _Pragma("unroll") for (int _i = 0; _i < 2; ++_i) \
        __builtin_amdgcn_global_load_lds((const unsigned*)((const char*)(gbase) + (voff)[_i]), (LAS unsigned*)(lds + (bufoff) + ldsw + _i * 8192), 16, 0, 0); } } while (0)
#define PG8_LDA(dst, b, h) do { if constexpr (VAR < 2) _Pragma("unroll") for (int m = 0; m < 4; ++m) _Pragma("unroll") for (int k = 0; k < 2; ++k) dst[m][k] = *(const LAS bf16x8*)(lds + PG8_SA(b, h) + aoff + m * 2048 + k * 1024); } while (0)
#define PG8_LDB(dst, b, h) do { if constexpr (VAR < 2) _Pragma("unroll") for (int n = 0; n < 2; ++n) _Pragma("unroll") for (int k = 0; k < 2; ++k) dst[n][k] = *(const LAS bf16x8*)(lds + PG8_SB(b, h) + boff + n * 2048 + k * 1024); } while (0)
#define PG8_MMA(ai, bj, At, Bt) do { __builtin_amdgcn_s_setprio(1); _Pragma("unroll") for (int m = 0; m < 4; ++m) _Pragma("unroll") for (int n = 0; n < 2; ++n) _Pragma("unroll") for (int k = 0; k < 2; ++k) \
        { if constexpr (I8) acc[ai][bj][m][n] = __builtin_bit_cast(f32x4, __builtin_amdgcn_mfma_i32_16x16x64_i8(__builtin_bit_cast(i32x4, Bt[n][k]), __builtin_bit_cast(i32x4, At[m][k]), __builtin_bit_cast(i32x4, acc[ai][bj][m][n]), 0, 0, 0)); \
          else acc[ai][bj][m][n] = __builtin_amdgcn_mfma_f32_16x16x32_bf16(Bt[n][k], At[m][k], acc[ai][bj][m][n], 0, 0, 0); } __builtin_amdgcn_s_setprio(0); } while (0)
#define PG8_WAIT_V(n) asm volatile("s_waitcnt vmcnt(" #n ")" ::: "memory")
#define PG8_WAIT_L(n) asm volatile("s_waitcnt lgkmcnt(" #n ")" ::: "memory")
#define PG8_BAR do { if constexpr (VAR != 3) __builtin_amdgcn_s_barrier(); } while (0)
#define PG8_SCHED __builtin_amdgcn_sched_barrier(0)
    Unit cur, nxt; int ui = 0;
    if (!S.next(0, cur)) return;
    f32x4 acc[2][2][4][2];
#pragma unroll
    for (int a = 0; a < 2; ++a)
#pragma unroll
        for (int b = 0; b < 2; ++b)
#pragma unroll
            for (int m = 0; m < 4; ++m)
#pragma unroll
                for (int n = 0; n < 2; ++n) acc[a][b][m][n] = (f32x4){0.f, 0.f, 0.f, 0.f};
    bf16x8 At[4][2], B0[2][2], B1[2][2];
    if constexpr (VAR >= 2) {
#pragma unroll
        for (int m = 0; m < 4; ++m)
#pragma unroll
            for (int k = 0; k < 2; ++k) { const unsigned h_ = (unsigned)(tid * 2654435761u + (m * 2 + k) * 40503u); const u32x4 q_ = (u32x4){h_ & 0x3fff3fffu, (h_ * 3u) & 0x3fff3fffu, (h_ * 5u) & 0x3fff3fffu, (h_ * 7u) & 0x3fff3fffu}; At[m][k] = __builtin_bit_cast(bf16x8, q_);
                if (m < 2) { B0[m][k] = __builtin_bit_cast(bf16x8, q_ ^ 0x01010101u); B1[m][k] = __builtin_bit_cast(bf16x8, q_ ^ 0x02040204u); } }
    }
    const char* cA = unitA(g, cur); const char* cB = unitB(g, cur);
    PG8_STAGE(PG8_SB(0, 0), cB, voffB); PG8_STAGE(PG8_SB(0, 1), cB + hstepB, voffB); PG8_STAGE(PG8_SA(0, 0), cA, voffA); PG8_STAGE(PG8_SA(0, 1), cA + hstepA, voffA);
    if (wr == 1) PG8_BAR;
    PG8_WAIT_V(2); PG8_BAR;
    PG8_STAGE(PG8_SB(1, 0), cB + kstep, voffB); PG8_STAGE(PG8_SA(1, 0), cA + kstep, voffA); PG8_STAGE(PG8_SB(1, 1), cB + hstepB + kstep, voffB);
    PG8_WAIT_V(6); PG8_BAR;
    for (;;) {
        const bool has_next = S.next(ui + 1, nxt);
        const char* nA = has_next ? unitA(g, nxt) : cA; const char* nB = has_next ? unitB(g, nxt) : cB;
        for (int t = 0; t < nt; t += 2) {
            const bool last = (t == nt - 2);
            const char* a1 = cA + (size_t)(t + 1) * kstep;
            const char* a2 = last ? nA : cA + (size_t)(t + 2) * kstep; const char* b2 = last ? nB : cB + (size_t)(t + 2) * kstep;
            const char* a3 = a2 + kstep; const char* b3 = b2 + kstep;
            PG8_LDB(B0, 0, 0); PG8_LDB(B1, 0, 1); PG8_SCHED; PG8_LDA(At, 0, 0); PG8_STAGE(PG8_SA(1, 1), a1 + hstepA, voffA);
            PG8_WAIT_V(8); PG8_WAIT_L(0); PG8_BAR; PG8_MMA(0, 0, At, B0); PG8_MMA(0, 1, At, B1); PG8_BAR; PG8_SCHED;
            PG8_LDA(At, 0, 1); PG8_STAGE(PG8_SB(0, 0), b2, voffB); PG8_STAGE(PG8_SB(0, 1), b2 + hstepB, voffB); PG8_STAGE(PG8_SA(0, 0), a2, voffA);
            PG8_WAIT_V(8); PG8_WAIT_L(0); PG8_BAR; PG8_MMA(1, 0, At, B0); PG8_MMA(1, 1, At, B1); PG8_BAR; PG8_SCHED;
            PG8_LDB(B0, 1, 0); PG8_LDB(B1, 1, 1); PG8_SCHED; PG8_LDA(At, 1, 0); PG8_STAGE(PG8_SA(0, 1), a2 + hstepA, voffA);
            PG8_WAIT_V(8); PG8_WAIT_L(0); PG8_BAR; PG8_MMA(0, 0, At, B0); PG8_MMA(0, 1, At, B1); PG8_BAR; PG8_SCHED;
            PG8_LDA(At, 1, 1); PG8_STAGE(PG8_SB(1, 0), b3, voffB); PG8_STAGE(PG8_SB(1, 1), b3 + hstepB, voffB); PG8_STAGE(PG8_SA(1, 0), a3, voffA);
            PG8_WAIT_V(8); PG8_WAIT_L(0); PG8_BAR; PG8_MMA(1, 0, At, B0); PG8_MMA(1, 1, At, B1); PG8_BAR; PG8_SCHED;
        }
        if (wr == 0) PG8_BAR;
        E(acc, cur, wr, wc, fr, fq, scr);
        if (!has_next) break;
#pragma unroll
        for (int a = 0; a < 2; ++a)
#pragma unroll
            for (int b = 0; b < 2; ++b)
#pragma unroll
                for (int m = 0; m < 4; ++m)
#pragma unroll
                    for (int n = 0; n < 2; ++n) acc[a][b][m][n] = (f32x4){0.f, 0.f, 0.f, 0.f};
        cur = nxt; cA = nA; cB = nB; ++ui;
        if (wr == 1) PG8_BAR;
    }
    PG8_WAIT_V(0);
    PG8_BAR;
#undef PG8_SA
#undef PG8_SB
#undef PG8_STAGE
#undef PG8_LDA
#undef PG8_LDB
#undef PG8_MMA
#undef PG8_WAIT_V
#undef PG8_WAIT_L
#undef PG8_BAR
#undef PG8_SCHED
}

#define EPI_ARGS f32x4 (&acc)[2][2][4][2], const Unit& u, int wr, int wc, int fr, int fq, LAS unsigned char* scr
#define EPI_BAR() do { asm volatile("s_waitcnt lgkmcnt(0)" ::: "memory"); __builtin_amdgcn_s_barrier(); asm volatile("" ::: "memory"); } while (0)

struct EpiBf16 {
    static constexpr bool PERM = true;
    bf16* O; int ldc; const float* colscale; float scale; int zdiv; size_t sChi, sClo;
    __device__ __forceinline__ void operator()(EPI_ARGS) const {
        bf16* base = O + (size_t)(u.z / zdiv) * sChi + (size_t)(u.z % zdiv) * sClo;
        const int row0 = u.pm * BM + wr * 64 + fr, col0 = u.pn * BM + wc * 32 + 8 * fq;
        f32x4 cs[2][2];
#pragma unroll
        for (int bj = 0; bj < 2; ++bj)
#pragma unroll
            for (int n = 0; n < 2; ++n) { cs[bj][n] = colscale ? *(const f32x4*)(colscale + col0 + bj * HALF + 4 * n) : (f32x4){1.f, 1.f, 1.f, 1.f}; cs[bj][n] = cs[bj][n] * scale; }
#pragma unroll
        for (int ai = 0; ai < 2; ++ai)
#pragma unroll
            for (int m = 0; m < 4; ++m) { bf16* rowp = base + (size_t)(row0 + ai * HALF + m * 16) * ldc + col0;
#pragma unroll
                for (int bj = 0; bj < 2; ++bj) { const f32x4 v0 = acc[ai][bj][m][0] * cs[bj][0], v1 = acc[ai][bj][m][1] * cs[bj][1];
                    u32x4 w; w.x = cvt_pk_bf16(v0[0], v0[1]); w.y = cvt_pk_bf16(v0[2], v0[3]); w.z = cvt_pk_bf16(v1[0], v1[1]); w.w = cvt_pk_bf16(v1[2], v1[3]);
                    *(u32x4*)(rowp + bj * HALF) = w; } }
    }
};

template <bool I8> struct EpiProj {
    static constexpr bool PERM = true;
    bf16 *U0, *CH, *BG; int pn_off; const float* sA; const unsigned* cmaxB; LAS float* rtab;
    __device__ __forceinline__ void operator()(EPI_ARGS) const {
        const int row0 = u.pm * BM + wr * 64 + fr, c8 = wc * 32 + 8 * fq, pn = u.pn + pn_off;
        if (I8) { if (__builtin_amdgcn_readfirstlane(((LAS int*)rtab)[256]) != u.pm) { EPI_BAR(); if (threadIdx.x < 256) rtab[threadIdx.x] = sA[u.pm * BM + threadIdx.x]; if (threadIdx.x == 0) ((LAS int*)rtab)[256] = u.pm; EPI_BAR(); } }
        if (I8 || pn < 32) {
            const bool glu = I8 || pn < 16;
            bf16* base = (glu ? U0 : CH) + (size_t)((pn & 15) * HALF + c8);
            f32x4 sb[2][2];
            if (I8) {
#pragma unroll
                for (int bj = 0; bj < 2; ++bj)
#pragma unroll
                    for (int n = 0; n < 2; ++n) { const u32x4 cm = *(const u32x4*)(cmaxB + pn * BM + bj * HALF + c8 + 4 * n); sb[bj][n] = (f32x4){__uint_as_float(cm.x), __uint_as_float(cm.y), __uint_as_float(cm.z), __uint_as_float(cm.w)} * (1.0f / 127.0f); } }
#pragma unroll
            for (int ai = 0; ai < 2; ++ai)
#pragma unroll
                for (int m = 0; m < 4; ++m) {
                    const float rs = I8 ? rtab[wr * 64 + fr + ai * HALF + m * 16] : 1.0f;
                    f32x4 o[2];
#pragma unroll
                    for (int n = 0; n < 2; ++n) { f32x4 a = acc[ai][0][m][n], b = acc[ai][1][m][n];
                        if (I8) { const i32x4 ia = __builtin_bit_cast(i32x4, a), ib = __builtin_bit_cast(i32x4, b);
                            a = (f32x4){(float)ia[0], (float)ia[1], (float)ia[2], (float)ia[3]} * (sb[0][n] * rs); b = (f32x4){(float)ib[0], (float)ib[1], (float)ib[2], (float)ib[3]} * (sb[1][n] * rs); }
#pragma unroll
                        for (int e = 0; e < 4; ++e) o[n][e] = glu ? a[e] * fast_sigmoid(b[e]) : a[e] * b[e]; }
                    u32x4 w; w.x = cvt_pk_bf16(o[0][0], o[0][1]); w.y = cvt_pk_bf16(o[0][2], o[0][3]); w.z = cvt_pk_bf16(o[1][0], o[1][1]); w.w = cvt_pk_bf16(o[1][2], o[1][3]);
                    *(u32x4*)(base + (size_t)(row0 + ai * HALF + m * 16) * CWID) = w; }
        } else {
            bf16* base = BG + (size_t)((pn - 32) * BM + c8);
#pragma unroll
            for (int ai = 0; ai < 2; ++ai)
#pragma unroll
                for (int m = 0; m < 4; ++m)
#pragma unroll
                    for (int bj = 0; bj < 2; ++bj) { const f32x4 v0 = acc[ai][bj][m][0], v1 = acc[ai][bj][m][1];
                        u32x4 w; w.x = cvt_pk_bf16(v0[0], v0[1]); w.y = cvt_pk_bf16(v0[2], v0[3]); w.z = cvt_pk_bf16(v1[0], v1[1]); w.w = cvt_pk_bf16(v1[2], v1[3]);
                        *(u32x4*)(base + (size_t)(row0 + ai * HALF + m * 16) * CWID + bj * HALF) = w; }
        }
    }
};

template <bool RES_BF16> struct EpiResid {
    static constexpr bool PERM = true;
    const void* resid; bf16* ob; float* rowsq; unsigned* rowmax; int ldc;
    __device__ __forceinline__ void operator()(EPI_ARGS) const {
        const int row0 = u.pm * BM + wr * 64 + fr, col0 = u.pn * BM + wc * 32 + 8 * fq;
        float ssv[8], mxv[8];
#pragma unroll
        for (int ai = 0; ai < 2; ++ai) {
            f32x4 r0[4][2], r1[4][2];
#pragma unroll
            for (int m = 0; m < 4; ++m)
#pragma unroll
                for (int bj = 0; bj < 2; ++bj) { const size_t off = (size_t)(row0 + ai * HALF + m * 16) * ldc + col0 + bj * HALF;
                    if (RES_BF16) { const u32x4 rw = *(const u32x4*)((const bf16*)resid + off); r0[m][bj] = __builtin_bit_cast(f32x4, rw); }
                    else { r0[m][bj] = *(const f32x4*)((const float*)resid + off); r1[m][bj] = *(const f32x4*)((const float*)resid + off + 4); } }
#pragma unroll
            for (int m = 0; m < 4; ++m) { const int row = row0 + ai * HALF + m * 16; const size_t off = (size_t)row * ldc + col0; float ss = 0.f, mx = 0.f;
#pragma unroll
                for (int bj = 0; bj < 2; ++bj) {
                    f32x4 a0, a1;
                    if (RES_BF16) { const u32x4 rw = __builtin_bit_cast(u32x4, r0[m][bj]); a0 = (f32x4){bf_lo(rw.x), bf_hi(rw.x), bf_lo(rw.y), bf_hi(rw.y)}; a1 = (f32x4){bf_lo(rw.z), bf_hi(rw.z), bf_lo(rw.w), bf_hi(rw.w)}; }
                    else { a0 = r0[m][bj]; a1 = r1[m][bj]; }
                    const f32x4 v0 = acc[ai][bj][m][0] + a0, v1 = acc[ai][bj][m][1] + a1;
                    u32x4 w; w.x = cvt_pk_bf16(v0[0], v0[1]); w.y = cvt_pk_bf16(v0[2], v0[3]); w.z = cvt_pk_bf16(v1[0], v1[1]); w.w = cvt_pk_bf16(v1[2], v1[3]); *(u32x4*)(ob + off + bj * HALF) = w;
                    ss += (v0[0] * v0[0] + v0[1] * v0[1]) + (v0[2] * v0[2] + v0[3] * v0[3]) + (v1[0] * v1[0] + v1[1] * v1[1]) + (v1[2] * v1[2] + v1[3] * v1[3]);
                    if (rowmax) mx = fmaxf(mx, fmaxf(fmaxf(fmaxf(fabsf(v0[0]), fabsf(v0[1])), fmaxf(fabsf(v0[2]), fabsf(v0[3]))), fmaxf(fmaxf(fabsf(v1[0]), fabsf(v1[1])), fmaxf(fabsf(v1[2]), fabsf(v1[3]))))); }
                ss += __shfl_xor(ss, 16); ss += __shfl_xor(ss, 32); ssv[ai * 4 + m] = ss;
                if (rowmax) { mx = fmaxf(mx, __shfl_xor(mx, 16)); mx = fmaxf(mx, __shfl_xor(mx, 32)); } mxv[ai * 4 + m] = mx; }
            asm volatile("" ::: "memory"); }
        float s0 = 0.f, s1 = 0.f, m0 = 0.f, m1 = 0.f;
#pragma unroll
        for (int k = 0; k < 8; ++k) if ((k >> 1) == fq) { if (k & 1) { s1 = ssv[k]; m1 = mxv[k]; } else { s0 = ssv[k]; m0 = mxv[k]; } }
        const int rq = row0 + (fq >> 1) * HALF + (fq & 1) * 32;
        __hip_atomic_fetch_add(rowsq + rq, s0, __ATOMIC_RELAXED, __HIP_MEMORY_SCOPE_AGENT); __hip_atomic_fetch_add(rowsq + rq + 16, s1, __ATOMIC_RELAXED, __HIP_MEMORY_SCOPE_AGENT);
        if (rowmax) { __hip_atomic_fetch_max(rowmax + rq, __float_as_uint(m0), __ATOMIC_RELAXED, __HIP_MEMORY_SCOPE_AGENT); __hip_atomic_fetch_max(rowmax + rq + 16, __float_as_uint(m1), __ATOMIC_RELAXED, __HIP_MEMORY_SCOPE_AGENT); }
    }
};

__device__ __forceinline__ float row_rstd(const float* rowsq, int row) { return 1.0f / sqrtf(__hip_atomic_load(rowsq + row, __ATOMIC_RELAXED, __HIP_MEMORY_SCOPE_AGENT) * (1.0f / DM) + EPS); }

struct EpiSoftmax {
    static constexpr bool PERM = true;
    bf16* P; const float* rowsq; int ldc;
    __device__ __forceinline__ void operator()(EPI_ARGS) const {
        LAS float* RM = (LAS float*)scr;
        LAS float* RS = RM + 1024;
        const int rl0 = wr * 64 + fr;
#pragma unroll
        for (int ai = 0; ai < 2; ++ai)
#pragma unroll
            for (int m = 0; m < 4; ++m) { const int rl = rl0 + ai * HALF + m * 16; const float rs = row_rstd(rowsq, u.pm * BM + rl); float mx = -3.0e38f;
#pragma unroll
                for (int bj = 0; bj < 2; ++bj)
#pragma unroll
                    for (int n = 0; n < 2; ++n) { acc[ai][bj][m][n] = acc[ai][bj][m][n] * rs; const f32x4 v = acc[ai][bj][m][n]; mx = fmaxf(mx, fmaxf(fmaxf(v[0], v[1]), fmaxf(v[2], v[3]))); }
                mx = fmaxf(mx, __shfl_xor(mx, 16)); mx = fmaxf(mx, __shfl_xor(mx, 32));
                if (fq == 0) RM[rl * 4 + wc] = mx; }
        EPI_BAR();
#pragma unroll
        for (int ai = 0; ai < 2; ++ai)
#pragma unroll
            for (int m = 0; m < 4; ++m) { const int rl = rl0 + ai * HALF + m * 16; const f32x4 m4 = *(const LAS f32x4*)(RM + rl * 4); const float mx = fmaxf(fmaxf(m4[0], m4[1]), fmaxf(m4[2], m4[3])); float sm = 0.f;
#pragma unroll
                for (int bj = 0; bj < 2; ++bj)
#pragma unroll
                    for (int n = 0; n < 2; ++n) { f32x4 v = acc[ai][bj][m][n];
#pragma unroll
                        for (int e = 0; e < 4; ++e) { v[e] = __builtin_amdgcn_exp2f(v[e] - mx); sm += v[e]; }
                        acc[ai][bj][m][n] = v; }
                sm += __shfl_xor(sm, 16); sm += __shfl_xor(sm, 32);
                if (fq == 0) RS[rl * 4 + wc] = sm; }
        EPI_BAR();
        const int row0 = u.pm * BM + rl0, col0 = u.pn * BM + wc * 32 + 8 * fq;
#pragma unroll
        for (int ai = 0; ai < 2; ++ai)
#pragma unroll
            for (int m = 0; m < 4; ++m) { const int rl = rl0 + ai * HALF + m * 16; const f32x4 s4 = *(const LAS f32x4*)(RS + rl * 4); const float inv = 1.0f / ((s4[0] + s4[1]) + (s4[2] + s4[3]));
                bf16* rowp = P + (size_t)(row0 + ai * HALF + m * 16) * ldc + col0;
#pragma unroll
                for (int bj = 0; bj < 2; ++bj) { const f32x4 v0 = acc[ai][bj][m][0] * inv, v1 = acc[ai][bj][m][1] * inv;
                    u32x4 w; w.x = cvt_pk_bf16(v0[0], v0[1]); w.y = cvt_pk_bf16(v0[2], v0[3]); w.z = cvt_pk_bf16(v1[0], v1[1]); w.w = cvt_pk_bf16(v1[2], v1[3]);
                    *(u32x4*)(rowp + bj * HALF) = w; } }
        EPI_BAR();
    }
};

template <bool I8, int NREP = 1> struct EpiGateUp {
    static constexpr bool PERM = true;
    bf16* F; const float* rowsq; const float* cw; float* tailG; float* headG; float* headU; const unsigned* rowmaxA; const unsigned* colmaxB; LAS float* rtab;
    __device__ __forceinline__ void operator()(EPI_ARGS) const {
        LAS float* H = (LAS float*)scr;
        if (__builtin_amdgcn_readfirstlane(((LAS int*)rtab)[256]) != u.pm) { EPI_BAR();
            if (threadIdx.x < 256) { const int row = u.pm * BM + threadIdx.x; float rs = row_rstd(rowsq, row); if (I8) rs *= __uint_as_float(__hip_atomic_load(rowmaxA + row, __ATOMIC_RELAXED, __HIP_MEMORY_SCOPE_AGENT)) * (1.0f / 127.0f); rtab[threadIdx.x] = rs; }
            if (threadIdx.x == 0) ((LAS int*)rtab)[256] = u.pm; EPI_BAR(); }
        const int c8 = wc * 32 + 8 * fq, j8 = u.pn * HALF + c8;
        f32x4 w0[2], w1[2], w2[2];
#pragma unroll
        for (int n = 0; n < 2; ++n) { w0[n] = *(const f32x4*)(cw + j8 + 4 * n); w1[n] = *(const f32x4*)(cw + FF + j8 + 4 * n); w2[n] = *(const f32x4*)(cw + 2 * FF + j8 + 4 * n); }
        f32x4 sb[2][2];
        if (I8) {
#pragma unroll
            for (int bj = 0; bj < 2; ++bj)
#pragma unroll
                for (int n = 0; n < 2; ++n) { const u32x4 cm = *(const u32x4*)(colmaxB + u.pn * BM + bj * HALF + c8 + 4 * n); sb[bj][n] = (f32x4){__uint_as_float(cm.x), __uint_as_float(cm.y), __uint_as_float(cm.z), __uint_as_float(cm.w)} * (1.0f / 127.0f); } }
#pragma unroll
        for (int ai = 0; ai < 2; ++ai)
#pragma unroll
            for (int m = 0; m < 4; ++m) { const int rl = ai * HALF + wr * 64 + m * 16 + fr; const float rs = rtab[rl];
#pragma unroll
                for (int bj = 0; bj < 2; ++bj)
#pragma unroll
                    for (int n = 0; n < 2; ++n) {
                        if (I8) { const i32x4 iv = __builtin_bit_cast(i32x4, acc[ai][bj][m][n]); acc[ai][bj][m][n] = (f32x4){(float)iv[0], (float)iv[1], (float)iv[2], (float)iv[3]} * (sb[bj][n] * rs); }
                        else acc[ai][bj][m][n] = acc[ai][bj][m][n] * rs; } }
#pragma unroll
        for (int rp_ = 0; rp_ < NREP; ++rp_) {
        if (fr >= 14) {
#pragma unroll
            for (int ai = 0; ai < 2; ++ai)
#pragma unroll
                for (int n = 0; n < 2; ++n) *(LAS f32x4*)(H + (((2 * ai + wr) * 2 + (fr - 14)) * HALF + c8 + 4 * n)) = acc[ai][0][3][n];
            if (wr == 1) {
#pragma unroll
                for (int n = 0; n < 2; ++n) *(f32x4*)(tailG + ((size_t)(u.pm * 2 + (fr - 14)) * FF + j8 + 4 * n)) = acc[1][0][3][n]; }
        }
        if (wr == 0 && fr < 2) {
#pragma unroll
            for (int n = 0; n < 2; ++n) { *(f32x4*)(headG + ((size_t)(u.pm * 2 + fr) * FF + j8 + 4 * n)) = acc[0][0][0][n]; *(f32x4*)(headU + ((size_t)(u.pm * 2 + fr) * FF + j8 + 4 * n)) = acc[0][1][0][n]; } }
        EPI_BAR();
#pragma unroll
        for (int ai = 0; ai < 2; ++ai) {
            const int rb = 2 * ai + wr;
            f32x4 py1[2], py0[2];
#pragma unroll
            for (int n = 0; n < 2; ++n) { py1[n] = (f32x4){0.f, 0.f, 0.f, 0.f}; py0[n] = py1[n]; }
#pragma unroll
            for (int m = 0; m < 4; ++m) {
                f32x4 o[2];
#pragma unroll
                for (int n = 0; n < 2; ++n) {
                    const f32x4 x = acc[ai][0][m][n], up = acc[ai][1][m][n];
                    f32x4 ht = (f32x4){0.f, 0.f, 0.f, 0.f};
                    if (m == 0) { const int hb = rb > 0 ? rb - 1 : 0; const float hz = rb > 0 ? 1.f : 0.f, s0 = (fr == 0) ? hz : 0.f, s1 = (fr == 1) ? hz : 0.f;
                        const f32x4 h62 = *(const LAS f32x4*)(H + ((hb * 2 + 0) * HALF + c8 + 4 * n)), h63 = *(const LAS f32x4*)(H + ((hb * 2 + 1) * HALF + c8 + 4 * n));
#pragma unroll
                        for (int e = 0; e < 4; ++e) ht[e] = s0 * (w1[n][e] * h63[e] + w0[n][e] * h62[e]) + s1 * (w0[n][e] * h63[e]); }
                    const f32x4 y1 = x * w1[n], y0 = x * w0[n];
#pragma unroll
                    for (int e = 0; e < 4; ++e) {
                        float gg = w2[n][e] * x[e];
                        gg += dpp_shr<1>(y1[e]);
                        gg += dpp_shr<2>(y0[e]);
                        if (m > 0) { gg += dpp_shl<15>(py1[n][e]); gg += dpp_shl<14>(py0[n][e]); }
                        else gg += ht[e];
                        o[n][e] = gg * fast_sigmoid(gg) * up[e];
                    }
                    py1[n] = y1; py0[n] = y0; }
                u32x4 w; w.x = cvt_pk_bf16(o[0][0], o[0][1]); w.y = cvt_pk_bf16(o[0][2], o[0][3]); w.z = cvt_pk_bf16(o[1][0], o[1][1]); w.w = cvt_pk_bf16(o[1][2], o[1][3]);
                *(u32x4*)(F + (size_t)(u.pm * BM + ai * HALF + wr * 64 + m * 16 + fr) * FF + j8) = w;
            } }
        EPI_BAR(); }
    }
};
}

constexpr size_t MiB = 1u << 20;
constexpr size_t WS_CTL = 0, CTL_ZERO_BYTES = 1 * MiB;
constexpr size_t WS_WIN = 1 * MiB;
constexpr size_t WS_XN = WS_WIN + 80 * MiB;
constexpr size_t WS_WOUT = WS_XN + 128 * MiB;
constexpr size_t WS_WKV = WS_WOUT + 32 * MiB;
constexpr size_t WS_WQ = WS_WKV + 64 * MiB;
constexpr size_t WS_WO = WS_WQ + 32 * MiB;
constexpr size_t WS_F = WS_WIN;
constexpr size_t WS_WGU = WS_WO + 32 * MiB;
constexpr size_t WS_A8 = WS_WGU + 86 * MiB;
constexpr size_t WS_WDN = WS_A8 + 64 * MiB;
constexpr size_t WS_MEMN = WS_WDN + 86 * MiB;
constexpr size_t WS_KV = WS_MEMN + 8 * MiB;
constexpr size_t WS_WQK = WS_KV + 16 * MiB;
constexpr size_t WS_VWO = WS_WQK + 32 * MiB;
constexpr size_t WS_HB = WS_VWO + 32 * MiB;
constexpr size_t WS_P = WS_HB + 128 * MiB;
constexpr size_t WS_WIN8 = WS_P + 32 * MiB;
constexpr size_t WS_XN8 = WS_WIN8 + 16 * MiB;
constexpr size_t WS_SA1 = WS_XN8 + 64 * MiB;
constexpr size_t WS_HALO = WS_SA1 + 1 * MiB;
constexpr size_t HALO_ONE = (size_t)64 * 2 * FF * 4;
constexpr size_t WS_END = WS_HALO + 18 * MiB;
static_assert(WS_F + (size_t)MTOK * FF * 2 <= WS_WGU, "F overlay");
static_assert(3 * HALO_ONE <= 18 * MiB, "halo");
constexpr int CW_BAR = 4096;
constexpr int CW_RSQ1 = 65536, CW_RSQ2 = CW_RSQ1 + MTOK, CW_RSQ3 = CW_RSQ2 + MTOK;
constexpr int CW_CMAX = CW_RSQ3 + MTOK;
constexpr int CW_RMAX = CW_CMAX + 2 * FF;
constexpr int CW_CMAX1 = CW_RMAX + MTOK;
static_assert((size_t)(CW_CMAX1 + 4096) * 4 <= CTL_ZERO_BYTES, "ctl");

constexpr int RING_OFF = 0, RING_BYTES = 131072;
constexpr int SCR_OFF = RING_BYTES;
constexpr int LDS_BYTES = 147456;
constexpr int MISC_OFF = LDS_BYTES - 128;
constexpr int NWAVES = 8;

#define XB_TMO      128
#define XB_XCNT(j)  (256  + 64 * (j))
#define XB_XSUB(j)  (1280 + 64 * (j))
#define XB_XGEN(j)  (2304 + 64 * (j))
#define XB_TOP      3328
#define XB_TOPGEN   3392
#define XCD_BAR_WORDS 3456
#define XB_SPIN_CAP (1u << 22)

__device__ __forceinline__ unsigned xb_ld(unsigned* p)              { return __hip_atomic_load(p, __ATOMIC_RELAXED, __HIP_MEMORY_SCOPE_AGENT); }
__device__ __forceinline__ unsigned xb_add(unsigned* p, unsigned v) { return __hip_atomic_fetch_add(p, v, __ATOMIC_RELAXED, __HIP_MEMORY_SCOPE_AGENT); }
__device__ __forceinline__ unsigned xb_xcc_id() { return (unsigned)__builtin_amdgcn_s_getreg((3 << 11) | 20) & 0xFu; }
#define XB_SPIN(cond, bar) do { unsigned _sp = 0; while (cond) { __builtin_amdgcn_s_sleep(1); \
    if ((++_sp & 255u) == 0u) { if (xb_ld(&(bar)[XB_TMO])) break; if (_sp > XB_SPIN_CAP) { atomicAdd(&(bar)[XB_TMO], 1u); break; } } } } while (0)

struct XcdBarrier { unsigned* bar; unsigned x; volatile LAS unsigned* st; };

__device__ __forceinline__ XcdBarrier xcd_barrier_post(unsigned* bar, volatile LAS unsigned* st) {
    XcdBarrier b; b.bar = bar; b.x = xb_xcc_id(); b.st = st;
    if (threadIdx.x == 0) (void)xb_add(&bar[XB_XCNT(b.x)], 1u);
    return b;
}
__device__ __forceinline__ void xcd_barrier_complete(unsigned* bar, unsigned x, unsigned& nloc, unsigned& nx) {
    const unsigned G = gridDim.x * gridDim.y * gridDim.z;
    unsigned sum, cnt, mine, sp = 0u;
    for (;;) {
        sum = 0u; cnt = 0u; mine = 0u;
#pragma unroll
        for (unsigned j = 0; j < 16; ++j) { const unsigned c = xb_ld(&bar[XB_XCNT(j)]); sum += c; cnt += (c > 0u) ? 1u : 0u; mine = (j == x) ? c : mine; }
        if (sum == G) break;
        __builtin_amdgcn_s_sleep(1);
        if ((++sp & 255u) == 0u) { if (xb_ld(&bar[XB_TMO])) break; if (sp > XB_SPIN_CAP) { atomicAdd(&bar[XB_TMO], 1u); break; } }
    }
    nloc = mine > 0u ? mine : 1u; nx = cnt > 0u ? cnt : 1u;
}
__device__ __forceinline__ void xcd_barrier(const XcdBarrier& b) {
    asm volatile("s_waitcnt vmcnt(0)" ::: "memory");
    __syncthreads();
    if (threadIdx.x == 0) {
        unsigned* bar = b.bar;
        __builtin_amdgcn_s_waitcnt(0);
        unsigned nloc = b.st[0], nx = b.st[1];
        if (nloc == 0u) { xcd_barrier_complete(bar, b.x, nloc, nx); b.st[0] = nloc; b.st[1] = nx; }
        const unsigned old = xb_add(&bar[XB_XSUB(b.x)], 1u);
        const unsigned gen = old / nloc;
        if (old + 1u == (gen + 1u) * nloc) {
            __builtin_amdgcn_fence(__ATOMIC_RELEASE, "agent");
            asm volatile("s_waitcnt vmcnt(0)" ::: "memory");
            const unsigned og = xb_add(&bar[XB_TOP], 1u);
            const unsigned tg = og / nx;
            if (og + 1u == (tg + 1u) * nx) xb_add(&bar[XB_TOPGEN], 1u);
            else XB_SPIN(xb_ld(&bar[XB_TOPGEN]) == tg, bar);
            __builtin_amdgcn_fence(__ATOMIC_ACQUIRE, "agent");
            xb_add(&bar[XB_XGEN(b.x)], 1u);
            asm volatile("s_waitcnt vmcnt(0)" ::: "memory");
        } else {
            XB_SPIN(xb_ld(&bar[XB_XGEN(b.x)]) == gen, bar);
            __builtin_amdgcn_fence(__ATOMIC_ACQUIRE, "agent");
            asm volatile("s_waitcnt vmcnt(0)" ::: "memory");
        }
    }
    __syncthreads();
}

#define LDS_WAIT() asm volatile("s_waitcnt lgkmcnt(0)" ::: "memory")

template <int MAP> __device__ __forceinline__ int rowmap(int n, int row_off) {
    if (MAP == 0) return row_off + n;
    if (MAP == 2) return 256 * (n >> 7) + (n & 127);
    if (MAP == 3) return 256 * (n >> 7) + 128 + (n & 127);
    const int seg = n >> 11, j = n & 2047;
    if (seg == 0) return 256 * (j >> 7) + (j & 127);
    if (seg == 1) return 256 * (j >> 7) + 128 + (j & 127);
    if (seg == 2) return 8192 + j;
    if (seg == 3) return 4096 + 256 * (j >> 7) + (j & 127);
    return 4096 + 256 * (j >> 7) + 128 + (j & 127);
}
template <int MAP> __device__ __forceinline__ void transpose_item(const float* W, int K, int N, bf16* WT, int row_off, const float* gk, LAS float* scr, int item, int lane) {
    const int nblk = N / 64, kb = item / nblk, nb = item % nblk, k0 = 64 * kb, n0 = 64 * nb;
    const int n4 = lane & 15, kr = lane >> 4;
    f32x4 v[16];
#pragma unroll
    for (int i = 0; i < 16; ++i) v[i] = *(const GAS f32x4*)(W + (size_t)(k0 + 4 * i + kr) * N + n0 + 4 * n4);
    if (gk) {
#pragma unroll
        for (int i = 0; i < 16; ++i) v[i] = v[i] * gk[k0 + 4 * i + kr]; }
#pragma unroll
    for (int i = 0; i < 16; ++i) { LAS float* d = scr + (4 * i + kr) * 65 + 4 * n4; d[0] = v[i][0]; d[1] = v[i][1]; d[2] = v[i][2]; d[3] = v[i][3]; }
    LDS_WAIT(); asm volatile("" ::: "memory");
    const int c = lane & 7, nn = lane >> 3;
#pragma unroll
    for (int j = 0; j < 8; ++j) { const int n = nn + 8 * j; const LAS float* s = scr + (8 * c) * 65 + n;
        u32x4 o; o.x = cvt_pk_bf16(s[0 * 65], s[1 * 65]); o.y = cvt_pk_bf16(s[2 * 65], s[3 * 65]); o.z = cvt_pk_bf16(s[4 * 65], s[5 * 65]); o.w = cvt_pk_bf16(s[6 * 65], s[7 * 65]);
        *(GAS u32x4*)(WT + (size_t)rowmap<MAP>(n0 + n, row_off) * K + k0 + 8 * c) = o; }
    LDS_WAIT(); asm volatile("" ::: "memory");
}
__device__ __forceinline__ unsigned pack4_i8(int a, int b, int c, int d) { return (unsigned)(a & 0xff) | ((unsigned)(b & 0xff) << 8) | ((unsigned)(c & 0xff) << 16) | ((unsigned)d << 24); }
__device__ __forceinline__ int quant_i8(float x, float inv) { return (int)fminf(fmaxf(__builtin_rintf(x * inv), -127.0f), 127.0f); }
template <int MAP> __device__ __forceinline__ void colmax_item(const float* W, int N, const float* gk, unsigned* cmax, int item, int lane) {
    const int nblk = N / 256, kb = item / nblk, nb = item % nblk, k0 = 64 * kb, n0 = 256 * nb + 4 * lane;
    f32x4 mx = (f32x4){0.f, 0.f, 0.f, 0.f};
#pragma unroll 16
    for (int k = 0; k < 64; ++k) { const f32x4 v = *(const GAS f32x4*)(W + (size_t)(k0 + k) * N + n0) * (gk ? gk[k0 + k] : 1.0f);
        mx[0] = fmaxf(mx[0], fabsf(v[0])); mx[1] = fmaxf(mx[1], fabsf(v[1])); mx[2] = fmaxf(mx[2], fabsf(v[2])); mx[3] = fmaxf(mx[3], fabsf(v[3])); }
#pragma unroll
    for (int e = 0; e < 4; ++e) __hip_atomic_fetch_max(cmax + rowmap<MAP>(n0 + e, 0), __float_as_uint(mx[e]), __ATOMIC_RELAXED, __HIP_MEMORY_SCOPE_AGENT);
}
template <int MAP> __device__ __forceinline__ void quant_item(const float* W, int K, int N, unsigned char* W8, const float* gk, const unsigned* cmax, LAS float* scr, int item, int lane) {
    const int nblk = N / 32, kb = item / nblk, nb = item % nblk, k0 = 128 * kb, n0 = 32 * nb;
    const int n4 = lane & 7, kr = lane >> 3;
    f32x4 v[16];
#pragma unroll
    for (int i = 0; i < 16; ++i) v[i] = *(const GAS f32x4*)(W + (size_t)(k0 + 8 * i + kr) * N + n0 + 4 * n4);
#pragma unroll
    for (int i = 0; i < 16; ++i) v[i] = v[i] * (gk ? gk[k0 + 8 * i + kr] : 1.0f);
#pragma unroll
    for (int i = 0; i < 16; ++i) { LAS float* d = scr + (8 * i + kr) * 33 + 4 * n4; d[0] = v[i][0]; d[1] = v[i][1]; d[2] = v[i][2]; d[3] = v[i][3]; }
    LDS_WAIT(); asm volatile("" ::: "memory");
    const int c = lane & 7, nn = lane >> 3;
#pragma unroll
    for (int j = 0; j < 4; ++j) { const int n = nn + 8 * j, dr = rowmap<MAP>(n0 + n, 0); const float cm = __uint_as_float(__hip_atomic_load(cmax + dr, __ATOMIC_RELAXED, __HIP_MEMORY_SCOPE_AGENT)); const float inv = cm > 0.f ? 127.0f / cm : 0.f;
        const LAS float* sp = scr + (16 * c) * 33 + n; int q[16];
#pragma unroll
        for (int t = 0; t < 16; ++t) q[t] = quant_i8(sp[t * 33], inv);
        u32x4 o; o.x = pack4_i8(q[0], q[1], q[2], q[3]); o.y = pack4_i8(q[4], q[5], q[6], q[7]); o.z = pack4_i8(q[8], q[9], q[10], q[11]); o.w = pack4_i8(q[12], q[13], q[14], q[15]);
        *(GAS u32x4*)(W8 + (size_t)dr * K + k0 + 16 * c) = o; }
    LDS_WAIT(); asm volatile("" ::: "memory");
}
__device__ __forceinline__ void quant_row_i8(const bf16* hrow, unsigned char* qrow, float amax, int lane) {
    const float inv = amax > 0.f ? 127.0f / amax : 0.f;
#pragma unroll
    for (int it = 0; it < 4; ++it) { const GAS u32x4* src = (const GAS u32x4*)(hrow + it * 1024 + lane * 16); const u32x4 a = src[0], b = src[1];
        u32x4 o;
        o.x = pack4_i8(quant_i8(bf_lo(a.x), inv), quant_i8(bf_hi(a.x), inv), quant_i8(bf_lo(a.y), inv), quant_i8(bf_hi(a.y), inv));
        o.y = pack4_i8(quant_i8(bf_lo(a.z), inv), quant_i8(bf_hi(a.z), inv), quant_i8(bf_lo(a.w), inv), quant_i8(bf_hi(a.w), inv));
        o.z = pack4_i8(quant_i8(bf_lo(b.x), inv), quant_i8(bf_hi(b.x), inv), quant_i8(bf_lo(b.y), inv), quant_i8(bf_hi(b.y), inv));
        o.w = pack4_i8(quant_i8(bf_lo(b.z), inv), quant_i8(bf_hi(b.z), inv), quant_i8(bf_lo(b.w), inv), quant_i8(bf_hi(b.w), inv));
        *(GAS u32x4*)(qrow + it * 1024 + lane * 16) = o; }
}
template <bool Q8> __device__ __forceinline__ void rms_rows(const float* X, const float* gain, bf16* O, unsigned char* Q, float* qs, int nrows, int m0, int mstep, int lane) {
    if (m0 >= nrows) return;
    f32x4 v[16];
#pragma unroll
    for (int j = 0; j < 16; ++j) v[j] = *((const GAS f32x4*)(X + (size_t)m0 * DM) + lane + 64 * j);
    for (int m = m0; m < nrows; m += mstep) {
        const int mn = (m + mstep < nrows) ? m + mstep : m;
        f32x4 nv[16];
#pragma unroll
        for (int j = 0; j < 16; ++j) nv[j] = *((const GAS f32x4*)(X + (size_t)mn * DM) + lane + 64 * j);
        float s = 0.f;
#pragma unroll
        for (int j = 0; j < 16; ++j) s += (v[j][0] * v[j][0] + v[j][1] * v[j][1]) + (v[j][2] * v[j][2] + v[j][3] * v[j][3]);
        const float rstd = 1.0f / sqrtf(wave_sum(s) * (1.0f / DM) + EPS);
        GAS u32x2* o8 = (GAS u32x2*)(O + (size_t)m * DM) + lane; float mx = 0.f;
#pragma unroll
        for (int j = 0; j < 16; ++j) { v[j] = v[j] * rstd * *((const GAS f32x4*)gain + lane + 64 * j); u32x2 w; w.x = cvt_pk_bf16(v[j][0], v[j][1]); w.y = cvt_pk_bf16(v[j][2], v[j][3]); o8[64 * j] = w;
            if (Q8) mx = fmaxf(mx, fmaxf(fmaxf(fabsf(v[j][0]), fabsf(v[j][1])), fmaxf(fabsf(v[j][2]), fabsf(v[j][3])))); }
        if (Q8) {
#pragma unroll
            for (int o = 1; o < 64; o <<= 1) mx = fmaxf(mx, __shfl_xor(mx, o));
            const float inv = mx > 0.f ? 127.0f / mx : 0.f;
            GAS unsigned* q4 = (GAS unsigned*)(Q + (size_t)m * DM) + lane;
#pragma unroll
            for (int j = 0; j < 16; ++j) q4[64 * j] = pack4_i8(quant_i8(v[j][0], inv), quant_i8(v[j][1], inv), quant_i8(v[j][2], inv), quant_i8(v[j][3], inv));
            if (lane == 0) qs[m] = mx * (1.0f / 127.0f);
        }
#pragma unroll
        for (int j = 0; j < 16; ++j) v[j] = nv[j];
    }
}

__device__ __forceinline__ void conv_a_wave(const bf16* U0, const float* cwp, const float* cb, const float* lg, const float* lb, bf16* MIX, LAS unsigned* T, int it0, int step, int nitems, int lane) {
    if (it0 >= nitems) return;
    const int lr = lane >> 4, lc = lane & 15;
    int cur_grp = -1; f32x2 w[CONVK]; f32x2 bias = (f32x2){0.f, 0.f}, gg = bias, bb = bias;
#pragma unroll
    for (int k = 0; k < CONVK; ++k) w[k] = (f32x2){0.f, 0.f};
    u32x4 v[16];
    auto load_tile = [&](int item) {
        const int tb = item >> 4, grp = item & 15, r0 = tb * 32; const bool first = (r0 % SEQ) == 0;
#pragma unroll
        for (int p = 0; p < 16; ++p) { const int rr = 4 * p + lr; const bool ok = rr < 62 && !(first && rr < 30); const int rc = ok ? rr : 30;
            const u32x4 t = *(const GAS u32x4*)(U0 + (size_t)(r0 - 30 + rc) * CWID + grp * 128 + lc * 8); v[p] = ok ? t : (u32x4){0u, 0u, 0u, 0u}; } };
    load_tile(it0);
    for (int item = it0; item < nitems; item += step) {
        const int tb = item >> 4, grp = item & 15, r0 = tb * 32;
        if (grp != cur_grp) { cur_grp = grp;
#pragma unroll
            for (int k = 0; k < CONVK; ++k) w[k] = *(const GAS f32x2*)(cwp + k * CWID + grp * 128 + 2 * lane);
            bias = *(const GAS f32x2*)(cb + grp * 128 + 2 * lane); gg = *(const GAS f32x2*)(lg + grp * 128 + 2 * lane); bb = *(const GAS f32x2*)(lb + grp * 128 + 2 * lane); }
#pragma unroll
        for (int p = 0; p < 16; ++p) { const int rr = 4 * p + lr; if (rr < 62) *(LAS u32x4*)(T + rr * 64 + lc * 4) = v[p]; }
        load_tile(item + step < nitems ? item + step : item);
        LDS_WAIT(); asm volatile("" ::: "memory");
#pragma unroll
        for (int s = 0; s < 2; ++s) {
            float o0[16], o1[16];
#pragma unroll
            for (int j = 0; j < 16; ++j) { o0[j] = bias[0]; o1[j] = bias[1]; }
#pragma unroll
            for (int i = 0; i < 46; ++i) { const unsigned xw = T[(16 * s + i) * 64 + lane]; const float x0 = bf_lo(xw), x1 = bf_hi(xw);
#pragma unroll
                for (int j = 0; j < 16; ++j) { const int k = i - j; if (k >= 0 && k < CONVK) { o0[j] += w[k][0] * x0; o1[j] += w[k][1] * x1; } } }
#pragma unroll
            for (int j = 0; j < 16; ++j) {
                const float mu = wave_sum(o0[j] + o1[j]) * (1.0f / 128.0f); const float d0 = o0[j] - mu, d1 = o1[j] - mu;
                const float rstd = 1.0f / sqrtf(wave_sum(d0 * d0 + d1 * d1) * (1.0f / 128.0f) + EPS);
                const float y0 = d0 * rstd * gg[0] + bb[0], y1 = d1 * rstd * gg[1] + bb[1];
                *(GAS unsigned*)(MIX + (size_t)(r0 + 16 * s + j) * DM + grp * 128 + 2 * lane) = cvt_pk_bf16(y0 * fast_sigmoid(y0), y1 * fast_sigmoid(y1)); }
        }
        LDS_WAIT(); asm volatile("" ::: "memory");
    }
}

struct Args { const float* in[22]; float* out; unsigned char* ws; int ph_lo, ph_hi; };
constexpr int N_PHASES = 10;

__global__ void __launch_bounds__(NWAVES * 64, 2) fwd_kernel(Args args) {
    extern __shared__ __attribute__((aligned(16))) unsigned char lds_raw[];
    LAS unsigned char* lds = (LAS unsigned char*)lds_raw;
    volatile LAS unsigned* MISC = (volatile LAS unsigned*)(lds + MISC_OFF);
    const int tid = threadIdx.x, wave = __builtin_amdgcn_readfirstlane(tid >> 6);
#define lane ((int)(threadIdx.x & 63u))
    const int G = gridDim.x; const int bx = blockIdx.x; const int vcu = (G % 8 == 0) ? (bx % 8) * (G / 8) + bx / 8 : bx;
    unsigned char* ws = args.ws;
    gu32* ctl = (gu32*)(ws + WS_CTL);
    const float* x = args.in[0]; const float* mem = args.in[1]; const float* g_mix = args.in[2]; const float* w_in = args.in[3];
    const float* conv_a_w = args.in[4]; const float* conv_a_b = args.in[5]; const float* ln_a_g = args.in[6]; const float* ln_a_b = args.in[7];
    const float* conv_b_w = args.in[8]; const float* w_out = args.in[9]; const float* g_xattn = args.in[10]; const float* g_mem = args.in[11];
    const float* w_q = args.in[12]; const float* w_k = args.in[13]; const float* w_v = args.in[14]; const float* w_o = args.in[15];
    const float* g_ffn = args.in[16]; const float* w_gate = args.in[17]; const float* w_up = args.in[18]; const float* conv_f_w = args.in[19];
    const float* w_down = args.in[20]; const float* g_final = args.in[21];
    float* out = args.out;
    bf16* WIN = (bf16*)(ws + WS_WIN); bf16* XN = (bf16*)(ws + WS_XN); bf16* MIX = XN; bf16* WOUT = (bf16*)(ws + WS_WOUT); bf16* WKV = (bf16*)(ws + WS_WKV);
    bf16* WQ = (bf16*)(ws + WS_WQ); bf16* WO = (bf16*)(ws + WS_WO); bf16* FB = (bf16*)(ws + WS_F); unsigned char* WGU8 = ws + WS_WGU; unsigned char* A8 = ws + WS_A8; unsigned char* WIN8 = ws + WS_WIN8; unsigned char* XN8 = ws + WS_XN8; float* sA1 = (float*)(ws + WS_SA1); bf16* WDN = (bf16*)(ws + WS_WDN);
    bf16* MEMN = (bf16*)(ws + WS_MEMN); bf16* KV = (bf16*)(ws + WS_KV); bf16* WQK = (bf16*)(ws + WS_WQK); bf16* VWO = (bf16*)(ws + WS_VWO);
    bf16* HB = (bf16*)(ws + WS_HB); bf16* PB = (bf16*)(ws + WS_P);
    float* tailG = (float*)(ws + WS_HALO); float* headG = (float*)(ws + WS_HALO + HALO_ONE); float* headU = (float*)(ws + WS_HALO + 2 * HALO_ONE);
    unsigned* cmax1U = (unsigned*)(ws + WS_CTL) + CW_CMAX1; unsigned* cmaxU = (unsigned*)(ws + WS_CTL) + CW_CMAX; unsigned* rmaxU = (unsigned*)(ws + WS_CTL) + CW_RMAX;
    float* rsq1 = (float*)(ws + WS_CTL) + CW_RSQ1; float* rsq2 = (float*)(ws + WS_CTL) + CW_RSQ2; float* rsq3 = (float*)(ws + WS_CTL) + CW_RSQ3;
    bf16* U0 = (bf16*)out; bf16* CH = U0 + (size_t)MTOK * CWID; bf16* BG = CH + (size_t)MTOK * CWID;

    if (tid < 32) MISC[tid] = 0u;
    __syncthreads();
    XcdBarrier bar; bar.bar = (unsigned*)(ctl + CW_BAR); bar.x = 0; bar.st = nullptr;
    if (MK_N_LAUNCHES == 1) bar = xcd_barrier_post((unsigned*)(ctl + CW_BAR), MISC + 8);
    const int lo = args.ph_lo, hi = args.ph_hi;
#define IN(k) (lo <= (k) && (k) < hi)
#define BOTH(k) (IN(k) && IN((k) + 1))
#define GRID_BAR() xcd_barrier(bar)
#define REPS(k) _Pragma("unroll") for (int rep_ = 0; rep_ <= ((DUP_MASK >> (k)) & 1); ++rep_)
    float* dummy_out = (float*)(ws + WS_END); float* dummy_rsq = (float*)(ws + WS_END + (size_t)MTOK * DM * 4);
    LAS unsigned char* ring = lds + RING_OFF; LAS unsigned char* scr = lds + SCR_OFF;
    const int gw = vcu * NWAVES + wave, NGW = G * NWAVES;

    if (IN(0)) { REPS(0) {
        LAS float* tscr = (LAS float*)(lds + wave * 16640);
        constexpr int I_IN = (DM / 64) * ((INW - 2 * CWID) / 64), I_SQ = (DM / 64) * (DM / 64), I_FF = (DM / 64) * (FF / 64), I_DN = (FF / 64) * (DM / 64);
        constexpr int NITEMS = I_IN + 2 * I_SQ; (void)I_FF; (void)I_DN;
        _Pragma("nounroll") for (int r11_ = 0; r11_ <= ((DUP_MASK >> 11) & 1); ++r11_)
        for (int it = gw; it < NITEMS; it += NGW) {
            int r = it;
            if (r < I_IN) { transpose_item<1>(w_in, DM, INW, WIN, 0, nullptr, tscr, (r / 96) * (INW / 64) + 64 + (r % 96), lane); continue; } r -= I_IN;
            if (r < I_SQ) { transpose_item<0>(w_k, DM, DM, WKV, 0, nullptr, tscr, r, lane); continue; } r -= I_SQ;
            transpose_item<0>(w_v, DM, DM, WKV, DM, nullptr, tscr, r, lane);
        }
        _Pragma("nounroll") for (int r12_ = 0; r12_ <= ((DUP_MASK >> 12) & 1); ++r12_)
        { constexpr int I_CM = (DM / 64) * (FF / 256);
          for (int it = gw; it < 2 * I_CM; it += NGW) { if (it < I_CM) colmax_item<2>(w_gate, FF, g_ffn, cmaxU, it, lane); else colmax_item<3>(w_up, FF, g_ffn, cmaxU, it - I_CM, lane); }
          for (int it = gw; it < (DM / 64) * 16; it += NGW) colmax_item<1>(w_in, INW, nullptr, cmax1U, (it / 16) * (INW / 256) + (it % 16), lane); }
        _Pragma("nounroll") for (int r13_ = 0; r13_ <= ((DUP_MASK >> 13) & 1); ++r13_)
        rms_rows<true>(x, g_mix, XN, XN8, sA1, MTOK, gw, NGW, lane);
        rms_rows<false>(mem, g_mem, MEMN, nullptr, nullptr, MMEM, gw, NGW, lane);
        __syncthreads(); }
        if (BOTH(0)) GRID_BAR();
    }

    if (IN(1)) {
        { pg8::Gemm g{MEMN, WKV, DM, DM, DM, 1, 1 << 30, 0, 0, 0, 0, 0}; pg8::BatchOrder S; S.init(MMEM / 256, 2 * DM / 256, 1, G, vcu);
          pg8::EpiBf16 E{KV, 2 * DM, nullptr, 1.0f, 1, 0, 0};
          pg8::gemm_phase(ring, scr, g, S, E); }
        { constexpr int NKV = (MMEM / 256) * (2 * DM / 256);
          const bool all = G <= NKV; if (all || vcu >= NKV) { const int cw_ = all ? gw : (vcu - NKV) * NWAVES + wave, ncw = all ? NGW : (G - NKV) * NWAVES;
            { LAS float* qscr = (LAS float*)(lds + wave * 16896); constexpr int I_Q1 = (DM / 128) * (2 * CWID / 32);
              for (int it = cw_; it < I_Q1; it += ncw) quant_item<1>(w_in, DM, INW, WIN8, nullptr, cmax1U, qscr, (it / 128) * (INW / 32) + (it % 128), lane); }
            __syncthreads();
            LAS float* tscr = (LAS float*)(lds + wave * 16640); constexpr int I_SQ = (DM / 64) * (DM / 64);
            for (int it = cw_; it < 2 * I_SQ; it += ncw) { if (it < I_SQ) transpose_item<0>(w_out, DM, DM, WOUT, 0, nullptr, tscr, it, lane); else transpose_item<0>(w_o, DM, DM, WO, 0, nullptr, tscr, it - I_SQ, lane); }
            for (size_t i = (size_t)(cw_ >> 3) * 512 + tid; i < (size_t)DM * DM / 8; i += (size_t)(ncw >> 3) * 512) {
                const f32x4 a = *((const GAS f32x4*)w_q + 2 * i), b = *((const GAS f32x4*)w_q + 2 * i + 1);
                u32x4 w; w.x = cvt_pk_bf16(a[0], a[1]); w.y = cvt_pk_bf16(a[2], a[3]); w.z = cvt_pk_bf16(b[0], b[1]); w.w = cvt_pk_bf16(b[2], b[3]);
                *((GAS u32x4*)WQ + i) = w; } } }
        GRID_BAR();
        REPS(1) {
        { pg8::Gemm g{(const bf16*)XN8, (const bf16*)WIN8, DM / 2, DM / 2, DM / 2, 1, 1 << 30, 0, 0, 0, 0, 0}; pg8::StaticOrder S; S.init(MTOK / 256, 2 * CWID / 256, G, bx);
          LAS float* rtab = (LAS float*)(scr + 4096); if (tid == 0) ((LAS int*)rtab)[256] = -1; __syncthreads();
          pg8::EpiProj<true> E{U0, CH, BG, 0, sA1, cmax1U, rtab};
          pg8::gemm_phase<true>(ring, scr, g, S, E); }
        { pg8::Gemm g{XN, WIN + (size_t)2 * CWID * DM, DM, DM, DM, 1, 1 << 30, 0, 0, 0, 0, 0}; pg8::StaticOrder S; S.init(MTOK / 256, (INW - 2 * CWID) / 256, G, bx);
          pg8::EpiProj<false> E{U0, CH, BG, 2 * CWID / 256, nullptr, nullptr, nullptr};
          pg8::gemm_phase(ring, scr, g, S, E); } }
        if (BOTH(1)) GRID_BAR();
    }

    if (IN(2)) {
        _Pragma("nounroll") for (int rep2_ = 0; rep2_ <= ((DUP_MASK >> 2) & 1); ++rep2_) {
        { LAS unsigned* T = (LAS unsigned*)(lds + wave * 15872);
          conv_a_wave(U0, conv_a_w, conv_a_b, ln_a_g, ln_a_b, MIX, T, gw, NGW, (MTOK / 32) * 16, lane); }
        for (size_t i = (size_t)vcu * 512 + tid; i < (size_t)(MTOK / 4) * (CWID / 8); i += (size_t)G * 512) {
            const int rq = (int)(i >> 8), ch = (int)(i & 255), row0 = rq * 4; const bool first = (row0 % SEQ) == 0;
            const u32x4 z4 = (u32x4){0u, 0u, 0u, 0u};
            u32x4 cv[6], bg[4];
#pragma unroll
            for (int r = 0; r < 6; ++r) cv[r] = (first && r < 2) ? z4 : *(const GAS u32x4*)(CH + (size_t)(row0 - 2 + r) * CWID + ch * 8);
#pragma unroll
            for (int r = 0; r < 4; ++r) bg[r] = *(const GAS u32x4*)(BG + (size_t)(row0 + r) * CWID + ch * 8);
            float w0[8], w1[8], w2[8];
#pragma unroll
            for (int h = 0; h < 2; ++h) { const f32x4 a = *(const GAS f32x4*)(conv_b_w + ch * 8 + 4 * h), b = *(const GAS f32x4*)(conv_b_w + CWID + ch * 8 + 4 * h), c = *(const GAS f32x4*)(conv_b_w + 2 * CWID + ch * 8 + 4 * h);
#pragma unroll
                for (int e = 0; e < 4; ++e) { w0[4 * h + e] = a[e]; w1[4 * h + e] = b[e]; w2[4 * h + e] = c[e]; } }
#pragma unroll
            for (int r = 0; r < 4; ++r) { unsigned ow[4];
#pragma unroll
                for (int p_ = 0; p_ < 4; ++p_) {
                    const float lo_ = bf_lo(bg[r][p_]) * (w0[2 * p_] * bf_lo(cv[r][p_]) + w1[2 * p_] * bf_lo(cv[r + 1][p_]) + w2[2 * p_] * bf_lo(cv[r + 2][p_]));
                    const float hi_ = bf_hi(bg[r][p_]) * (w0[2 * p_ + 1] * bf_hi(cv[r][p_]) + w1[2 * p_ + 1] * bf_hi(cv[r + 1][p_]) + w2[2 * p_ + 1] * bf_hi(cv[r + 2][p_]));
                    ow[p_] = cvt_pk_bf16(lo_, hi_); }
                *(GAS u32x4*)(MIX + (size_t)(row0 + r) * DM + CWID + ch * 8) = (u32x4){ow[0], ow[1], ow[2], ow[3]}; }
        }
        __syncthreads(); }
        REPS(10) {
        { pg8::Gemm g{KV, WQ, 2 * DM, DM, HDIM, 4, 1 << 30, (size_t)MEMLEN * 2 * DM, (size_t)HDIM, 0, (size_t)HDIM, 0}; pg8::BatchOrder S; S.init(1, DM / 256, 16, G, vcu);
          pg8::EpiBf16 E{WQK, DM, g_xattn, 0.03125f * LOG2E, 16, 0, (size_t)MEMLEN * DM};
          pg8::gemm_phase(ring, scr, g, S, E); }
        { pg8::Gemm g{WO, KV + DM, DM, 2 * DM, HDIM, 4, 1 << 30, 0, (size_t)HDIM, (size_t)MEMLEN * 2 * DM, (size_t)HDIM, 0}; pg8::BatchOrder S; S.init(DM / 256, 1, 16, G, vcu);
          pg8::EpiBf16 E{VWO, NHEAD * MEMLEN, nullptr, 1.0f, 4, (size_t)DM * NHEAD * MEMLEN, (size_t)MEMLEN};
          pg8::gemm_phase(ring, scr, g, S, E); } }
        if (BOTH(2)) GRID_BAR();
    }

    if (IN(3)) {
        pg8::Gemm g{MIX, WOUT, DM, DM, DM, 1, 1 << 30, 0, 0, 0, 0, 0}; pg8::StaticOrder S; S.init(MTOK / 256, DM / 256, G, bx);
        constexpr int I_Q8 = (DM / 128) * (FF / 32); const int hq = G >> 1;
        if ((bx & 1) && hq > 0) { LAS float* qscr = (LAS float*)(lds + wave * 16896);
            for (int it = (bx >> 1) * NWAVES + wave; it < I_Q8; it += hq * NWAVES) quant_item<2>(w_gate, DM, FF, WGU8, g_ffn, cmaxU, qscr, it, lane);
            __syncthreads(); }
        REPS(3) { pg8::EpiResid<false> E{x, HB, rep_ ? dummy_rsq : rsq1, nullptr, DM};
        pg8::gemm_phase(ring, scr, g, S, E); }
        if (!(bx & 1) || hq == 0) { LAS float* qscr = (LAS float*)(lds + wave * 16896); const int nq = hq > 0 ? (G - hq) : G, iq = hq > 0 ? (bx >> 1) : bx;
            for (int it = iq * NWAVES + wave; it < I_Q8; it += nq * NWAVES) quant_item<3>(w_up, DM, FF, WGU8, g_ffn, cmaxU, qscr, it, lane);
            if (hq == 0) for (int it = iq * NWAVES + wave; it < I_Q8; it += nq * NWAVES) quant_item<2>(w_gate, DM, FF, WGU8, g_ffn, cmaxU, qscr, it, lane); }
        if (BOTH(3)) GRID_BAR();
    }

    if (IN(4)) {
        pg8::Gemm g{HB, WQK, DM, DM, DM, 1, SEQ / 256, 0, 0, 0, 0, (size_t)NHEAD * MEMLEN * DM}; pg8::StaticOrder S; S.init(MTOK / 256, NHEAD, G, bx);
        pg8::EpiSoftmax E{PB, rsq1, NHEAD * MEMLEN};
        REPS(4) pg8::gemm_phase(ring, scr, g, S, E);
        if (BOTH(4)) GRID_BAR();
    }

    if (IN(5)) {
        pg8::Gemm g{PB, VWO, NHEAD * MEMLEN, NHEAD * MEMLEN, NHEAD * MEMLEN, 1, SEQ / 256, 0, 0, 0, 0, (size_t)DM * NHEAD * MEMLEN}; pg8::StaticOrder S; S.init(MTOK / 256, DM / 256, G, bx);
        REPS(5) { pg8::EpiResid<true> E{HB, rep_ ? (bf16*)dummy_out : HB, rep_ ? dummy_rsq : rsq2, rep_ ? (unsigned*)nullptr : rmaxU, DM};
        pg8::gemm_phase(ring, scr, g, S, E); }
        GRID_BAR();
        for (int m = gw; m < MTOK; m += NGW) quant_row_i8(HB + (size_t)m * DM, A8 + (size_t)m * DM, __uint_as_float(__hip_atomic_load(rmaxU + m, __ATOMIC_RELAXED, __HIP_MEMORY_SCOPE_AGENT)), lane);
        if (BOTH(5)) GRID_BAR();
    }

    if (IN(6)) {
        pg8::Gemm g{(const bf16*)A8, (const bf16*)WGU8, DM / 2, DM / 2, DM / 2, 1, 1 << 30, 0, 0, 0, 0, 0}; pg8::StaticOrder S; S.init(MTOK / 256, 2 * FF / 256, G, bx);
        LAS float* rtab = (LAS float*)(scr + 4096); if (tid == 0) ((LAS int*)rtab)[256] = -1; __syncthreads();
        pg8::EpiGateUp<true, 1 + ((DUP_MASK >> 17) & 1)> E{FB, rsq2, conv_f_w, tailG, headG, headU, rmaxU, cmaxU, rtab};
        REPS(6) pg8::gemm_phase<true>(ring, scr, g, S, E);
    }
    if (IN(6)) {
        constexpr int NU = (2 * FF / 256) * (MTOK / 256); const int last = NU / G, used = NU - last * G, nfree = G - used, myidx = bx - used;
        if (myidx >= 0) { LAS float* tscr = (LAS float*)(lds + wave * 16640); constexpr int I_DN = (FF / 64) * (DM / 64);
            for (int it = myidx * NWAVES + wave; it < I_DN; it += nfree * NWAVES) transpose_item<0>(w_down, FF, DM, WDN, 0, nullptr, tscr, it, lane); }
        if (BOTH(6)) GRID_BAR();
    }

    if (IN(7)) {
        for (size_t i = (size_t)vcu * 512 + tid; i < (size_t)64 * FF; i += (size_t)G * 512) {
            const int pm = (int)(i / FF), j = (int)(i % FF);
            if ((pm & 15) == 0) continue;
            const float t0 = tailG[(size_t)((pm - 1) * 2 + 0) * FF + j], t1 = tailG[(size_t)((pm - 1) * 2 + 1) * FF + j];
            const float g0 = headG[(size_t)(pm * 2 + 0) * FF + j], g1 = headG[(size_t)(pm * 2 + 1) * FF + j];
            const float u0 = headU[(size_t)(pm * 2 + 0) * FF + j], u1 = headU[(size_t)(pm * 2 + 1) * FF + j];
            const float c0 = conv_f_w[j], c1 = conv_f_w[FF + j], c2 = conv_f_w[2 * FF + j];
            const float a0 = c2 * g0 + c1 * t1 + c0 * t0, a1 = c2 * g1 + c1 * g0 + c0 * t1;
            const unsigned p0 = cvt_pk_bf16(a0 * fast_sigmoid(a0) * u0, 0.f), p1 = cvt_pk_bf16(a1 * fast_sigmoid(a1) * u1, 0.f);
            FB[(size_t)(pm * 256 + 0) * FF + j] = (bf16)(p0 & 0xffffu); FB[(size_t)(pm * 256 + 1) * FF + j] = (bf16)(p1 & 0xffffu);
        }
        if (BOTH(7)) GRID_BAR();
    }

    if (IN(8)) {
        pg8::Gemm g{FB, WDN, FF, FF, FF, 1, 1 << 30, 0, 0, 0, 0, 0}; pg8::BatchOrder S; S.init(MTOK / 256, DM / 256, 1, G, vcu);
        { pg8::EpiResid<true> E{HB, HB, rsq3, nullptr, DM}; pg8::gemm_phase(ring, scr, g, S, E); }
        if ((DUP_MASK >> 8) & 1) { pg8::EpiResid<true> E{HB, (bf16*)dummy_out, dummy_rsq, nullptr, DM}; pg8::gemm_phase<false, DUP_VAR>(ring, scr, g, S, E); }
        if (BOTH(8)) GRID_BAR();
    }

    if (IN(9)) {
        if ((DUP_MASK >> 14) & 1) { _Pragma("nounroll") for (int r14_ = 0; r14_ < 8; ++r14_) GRID_BAR(); }
        const bool bad = (MK_N_LAUNCHES == 1) && (__hip_atomic_load(ctl + CW_BAR + XB_TMO, __ATOMIC_RELAXED, __HIP_MEMORY_SCOPE_AGENT) != 0u);
        REPS(9) { const bool dup_ = rep_ < ((DUP_MASK >> 9) & 1);
        f32x4 g0[8], g1[8];
#pragma unroll
        for (int j = 0; j < 8; ++j) { g0[j] = *((const GAS f32x4*)g_final + 2 * lane + 128 * j); g1[j] = *((const GAS f32x4*)g_final + 2 * lane + 128 * j + 1); }
        for (int m = gw; m < MTOK; m += 4 * NGW) {
            int mr[4]; float rr[4]; u32x4 hv[4][8];
#pragma unroll
            for (int q = 0; q < 4; ++q) { mr[q] = (m + q * NGW < MTOK) ? m + q * NGW : m; rr[q] = bad ? __builtin_nanf("") : pg8::row_rstd(rsq3, mr[q]); }
#pragma unroll
            for (int q = 0; q < 4; ++q)
#pragma unroll
                for (int j = 0; j < 8; ++j) hv[q][j] = *((const GAS u32x4*)(HB + (size_t)mr[q] * DM) + lane + 64 * j);
#pragma unroll
            for (int q = 0; q < 4; ++q) { if (q > 0 && mr[q] == m) continue;
                GAS f32x4* w = (GAS f32x4*)((dup_ ? dummy_out : out) + (size_t)mr[q] * DM) + 2 * lane;
#pragma unroll
                for (int j = 0; j < 8; ++j) { const u32x4 h = hv[q][j];
                    w[128 * j] = (f32x4){bf_lo(h.x), bf_hi(h.x), bf_lo(h.y), bf_hi(h.y)} * rr[q] * g0[j]; w[128 * j + 1] = (f32x4){bf_lo(h.z), bf_hi(h.z), bf_lo(h.w), bf_hi(h.w)} * rr[q] * g1[j]; } }
        } }
    }
#undef IN
#undef BOTH
#undef GRID_BAR
#undef lane
}

extern "C" void kernel_launch(void* const* d_in, const int* in_sizes, int n_in, void* d_out, int out_size, void* d_ws, size_t ws_size, hipStream_t stream) {
    static int grid = 0;
    if (grid == 0) {
        if (n_in != 22 || in_sizes[0] != MTOK * DM || out_size != MTOK * DM || ws_size < WS_END + (DUP_MASK ? (size_t)257 * MiB : 0)) { fprintf(stderr, "kernel_launch: unexpected shapes (n_in %d, in0 %d, out %d, ws %zu < %zu)\n", n_in, n_in > 0 ? in_sizes[0] : -1, out_size, ws_size, (size_t)WS_END); grid = -1; return; }
        int dev = 0, cus = 0, per_cu = 0;
        if (hipGetDevice(&dev) != hipSuccess || hipDeviceGetAttribute(&cus, hipDeviceAttributeMultiprocessorCount, dev) != hipSuccess) { grid = -1; return; }
        if (hipFuncSetAttribute((const void*)fwd_kernel, hipFuncAttributeMaxDynamicSharedMemorySize, LDS_BYTES) != hipSuccess) { fprintf(stderr, "kernel_launch: hipFuncSetAttribute failed\n"); grid = -1; return; }
        if (hipOccupancyMaxActiveBlocksPerMultiprocessor(&per_cu, (const void*)fwd_kernel, NWAVES * 64, LDS_BYTES) != hipSuccess || per_cu < 1) { fprintf(stderr, "kernel_launch: occupancy query says %d\n", per_cu); }
        (void)hipGetLastError();
        grid = cus;
    }
    if (grid < 0) return;
    if (hipMemsetAsync((char*)d_ws + WS_CTL, 0, CTL_ZERO_BYTES, stream) != hipSuccess) return;
    Args a{};
    for (int i = 0; i < 22; ++i) a.in[i] = (const float*)d_in[i];
    a.out = (float*)d_out; a.ws = (unsigned char*)d_ws;
    if (MK_N_LAUNCHES == 1) {
        a.ph_lo = 0; a.ph_hi = N_PHASES;
        hipLaunchKernelGGL(fwd_kernel, dim3(grid), dim3(NWAVES * 64), LDS_BYTES, stream, a);
    } else {
        for (int p = 0; p < N_PHASES; ++p) { a.ph_lo = p; a.ph_hi = p + 1; hipLaunchKernelGGL(fwd_kernel, dim3(grid), dim3(NWAVES * 64), LDS_BYTES, stream, a); }
    }
}
```

```cpp
#include <hip/hip_runtime.h>
#include <cstdio>

#ifndef MK_N_LAUNCHES
#define MK_N_LAUNCHES 1
#endif
static_assert(MK_N_LAUNCHES == 1, "phases P1 and P5 contain grid barriers of their own: only the one-launch build is supported");
#ifndef DUP_VAR
#define DUP_VAR 0
#endif
#ifndef DUP_MASK
#define DUP_MASK 0x0
#endif

#define GAS __attribute__((address_space(1)))
#define LAS __attribute__((address_space(3)))
typedef unsigned short bf16;
typedef short bf16x8 __attribute__((ext_vector_type(8)));
typedef float f32x4 __attribute__((ext_vector_type(4)));
typedef float f32x2 __attribute__((ext_vector_type(2)));
typedef unsigned u32x4 __attribute__((ext_vector_type(4)));
typedef unsigned u32x2 __attribute__((ext_vector_type(2)));
typedef int i32x4 __attribute__((ext_vector_type(4)));
typedef GAS unsigned gu32;

constexpr int DM = 4096, NBATCH = 4, SEQ = 4096, MTOK = NBATCH * SEQ, MEMLEN = 256, MMEM = NBATCH * MEMLEN;
constexpr int CWID = 2048;
constexpr int INW = 10240;
constexpr int FF = 11008;
constexpr int NHEAD = 4, HDIM = 1024;
constexpr int CONVK = 31;
constexpr float EPS = 1e-6f;
constexpr float LOG2E = 1.4426950408889634f;

__device__ __forceinline__ unsigned cvt_pk_bf16(float lo, float hi) { unsigned r; asm volatile("v_cvt_pk_bf16_f32 %0, %1, %2" : "=v"(r) : "v"(lo), "v"(hi)); return r; }
__device__ __forceinline__ float bf_lo(unsigned w) { return __uint_as_float(w << 16); }
__device__ __forceinline__ float bf_hi(unsigned w) { return __uint_as_float(w & 0xffff0000u); }
__device__ __forceinline__ float fast_sigmoid(float x) { return __builtin_amdgcn_rcpf(1.0f + __builtin_amdgcn_exp2f(-x * LOG2E)); }
template <int N> __device__ __forceinline__ float dpp_shr(float v) { return __int_as_float(__builtin_amdgcn_update_dpp(0, __float_as_int(v), 0x110 + N, 0xf, 0xf, true)); }
template <int N> __device__ __forceinline__ float dpp_shl(float v) { return __int_as_float(__builtin_amdgcn_update_dpp(0, __float_as_int(v), 0x100 + N, 0xf, 0xf, true)); }
__device__ __forceinline__ float wave_sum(float v) {
#pragma unroll
    for (int o = 1; o < 64; o <<= 1) v += __shfl_xor(v, o);
    return v;
}

namespace pg8 {
constexpr int BM = 256, BK = 64, HALF = 128, HTB = HALF * BK * 2, STAGE_BYTES = 8 * HTB, NXCD = 8, WGM = 8;
__host__ __device__ __forceinline__ int lds_byte(int r, int c) { const int st = (r >> 4) * 2 + (c >> 5), rr = r & 15, cc = c & 31, ob = rr * 64 + cc * 2; return st * 1024 + (ob ^ (((ob >> 9) & 1) << 5)); }
__host__ __device__ __forceinline__ void stage_rc(int b, int& R, int& C) { const int st = b / 1024, sb = b % 1024, swz = sb ^ (((sb >> 9) & 1) << 5); R = (st >> 1) * 16 + swz / 64; C = (st & 1) * 32 + (swz % 64) / 2; }
__host__ __device__ __forceinline__ int perm32(int rho) { const int n = rho >> 4, i = rho & 15; return 8 * (i >> 2) + 4 * n + (i & 3); }

struct Unit { int pm, pn, z; };
struct Gemm { const bf16* A; const bf16* Bt; int lda, ldb, K, zdiv, bdiv; size_t sAhi, sAlo, sBhi, sBlo, sBpm; };
__device__ __forceinline__ const char* unitA(const Gemm& g, const Unit& u) { return (const char*)(g.A + (size_t)(u.z / g.zdiv) * g.sAhi + (size_t)(u.z % g.zdiv) * g.sAlo + (size_t)u.pm * BM * g.lda); }
__device__ __forceinline__ const char* unitB(const Gemm& g, const Unit& u) { return (const char*)(g.Bt + (size_t)(u.z / g.zdiv) * g.sBhi + (size_t)(u.z % g.zdiv) * g.sBlo + (size_t)(u.pm / g.bdiv) * g.sBpm + (size_t)u.pn * BM * g.ldb); }

struct StaticOrder {
    int nM, nN, nwg, G, c;
    __device__ void init(int nM_, int nN_, int G_, int c_) { nM = nM_; nN = nN_; nwg = nM * nN; G = G_; c = c_; }
    __device__ bool next(int i, Unit& u) const {
        const long L = (long)i * G + c; if (L >= nwg) return false;
        int wgid = (int)L; { const int q = nwg / NXCD, r = nwg % NXCD, xcd = wgid % NXCD, off = wgid / NXCD; wgid = (xcd < r ? xcd * (q + 1) : r * (q + 1) + (xcd - r) * q) + off; }
        const int nig = WGM * nN, gid = wgid / nig, fm = gid * WGM, gsz = (nM - fm) < WGM ? (nM - fm) : WGM;
        u.pm = fm + ((wgid % nig) % gsz); u.pn = (wgid % nig) / gsz; u.z = 0; return true;
    }
};
struct BatchOrder {
    int nM, nN, nZ, G, c;
    __device__ void init(int nM_, int nN_, int nZ_, int G_, int c_) { nM = nM_; nN = nN_; nZ = nZ_; G = G_; c = c_; }
    __device__ bool next(int i, Unit& u) const {
        const long L = (long)i * G + c; if (L >= (long)nM * nN * nZ) return false;
        const int per = nM * nN, l = (int)L; u.z = l / per; const int rem = l % per; u.pm = rem / nN; u.pn = rem % nN; return true;
    }
};

template <bool I8 = false, int VAR = 0, class Epi, class Sched>
__device__ __forceinline__ void gemm_phase(LAS unsigned char* lds, LAS unsigned char* scr, const Gemm g, const Sched& S, const Epi& E) {
    const int tid = threadIdx.x, wid = __builtin_amdgcn_readfirstlane(tid >> 6), lane = tid & 63, wr = wid >> 2, wc = wid & 3, fr = lane & 15, fq = lane >> 4;
    const int K = g.K, nt = K / BK;
    unsigned voffA[2], voffB[2];
#pragma unroll
    for (int i = 0; i < 2; ++i) { int R, C; stage_rc(tid * 16 + i * 8192, R, C); const int Rb = Epi::PERM ? ((R & ~31) + perm32(R & 31)) : R;
        voffA[i] = (unsigned)(R * g.lda + C) * 2u; voffB[i] = (unsigned)(Rb * g.ldb + C) * 2u; }
    const size_t kstep = (size_t)(BK * 2);
    const size_t hstepA = (size_t)HALF * g.lda * 2, hstepB = (size_t)HALF * g.ldb * 2;
    const unsigned ldsw = (unsigned)wid * 1024u;
    const int aoff = lds_byte(wr * 64 + fr, fq * 8), boff = lds_byte(wc * 32 + fr, fq * 8);
#define PG8_SA(b, h) (((b) * 2 + (h)) * HTB)
#define PG8_SB(b, h) ((4 + (b) * 2 + (h)) * HTB)
#define PG8_STAGE(bufoff, gbase, voff) do { if constexpr (VAR != 1 && VAR != 3) { _Pragma("unroll") for (int _i = 0; _i < 2; ++_i) \
        __builtin_amdgcn_global_load_lds((const unsigned*)((const char*)(gbase) + (voff)[_i]), (LAS unsigned*)(lds + (bufoff) + ldsw + _i * 8192), 16, 0, 0); } } while (0)
#define PG8_LDA(dst, b, h) do { if constexpr (VAR < 2) _Pragma("unroll") for (int m = 0; m < 4; ++m) _Pragma("unroll") for (int k = 0; k < 2; ++k) dst[m][k] = *(const LAS bf16x8*)(lds + PG8_SA(b, h) + aoff + m * 2048 + k * 1024); } while (0)
#define PG8_LDB(dst, b, h) do { if constexpr (VAR < 2) _Pragma("unroll") for (int n = 0; n < 2; ++n) _Pragma("unroll") for (int k = 0; k < 2; ++k) dst[n][k] = *(const LAS bf16x8*)(lds + PG8_SB(b, h) + boff + n * 2048 + k * 1024); } while (0)
#define PG8_MMA(ai, bj, At, Bt) do { __builtin_amdgcn_s_setprio(1); _Pragma("unroll") for (int m = 0; m < 4; ++m) _Pragma("unroll") for (int n = 0; n < 2; ++n) _Pragma("unroll") for (int k = 0; k < 2; ++k) \
        { if constexpr (I8) acc[ai][bj][m][n] = __builtin_bit_cast(f32x4, __builtin_amdgcn_mfma_i32_16x16x64_i8(__builtin_bit_cast(i32x4, Bt[n][k]), __builtin_bit_cast(i32x4, At[m][k]), __builtin_bit_cast(i32x4, acc[ai][bj][m][n]), 0, 0, 0)); \
          else acc[ai][bj][m][n] = __builtin_amdgcn_mfma_f32_16x16x32_bf16(Bt[n][k], At[m][k], acc[ai][bj][m][n], 0, 0, 0); } __builtin_amdgcn_s_setprio(0); } while (0)
#define PG8_WAIT_V(n) asm volatile("s_waitcnt vmcnt(" #n ")" ::: "memory")
#define PG8_WAIT_L(n) asm volatile("s_waitcnt lgkmcnt(" #n ")" ::: "memory")
#define PG8_BAR do { if constexpr (VAR != 3) __builtin_amdgcn_s_barrier(); } while (0)
#define PG8_SCHED __builtin_amdgcn_sched_barrier(0)
    Unit cur, nxt; int ui = 0;
    if (!S.next(0, cur)) return;
    f32x4 acc[2][2][4][2];
#pragma unroll
    for (int a = 0; a < 2; ++a)
#pragma unroll
        for (int b = 0; b < 2; ++b)
#pragma unroll
            for (int m = 0; m < 4; ++m)
#pragma unroll
                for (int n = 0; n < 2; ++n) acc[a][b][m][n] = (f32x4){0.f, 0.f, 0.f, 0.f};
    bf16x8 At[4][2], B0[2][2], B1[2][2];
    if constexpr (VAR >= 2) {
#pragma unroll
        for (int m = 0; m < 4; ++m)
#pragma unroll
            for (int k = 0; k < 2; ++k) { const unsigned h_ = (unsigned)(tid * 2654435761u + (m * 2 + k) * 40503u); const u32x4 q_ = (u32x4){h_ & 0x3fff3fffu, (h_ * 3u) & 0x3fff3fffu, (h_ * 5u) & 0x3fff3fffu, (h_ * 7u) & 0x3fff3fffu}; At[m][k] = __builtin_bit_cast(bf16x8, q_);
                if (m < 2) { B0[m][k] = __builtin_bit_cast(bf16x8, q_ ^ 0x01010101u); B1[m][k] = __builtin_bit_cast(bf16x8, q_ ^ 0x02040204u); } }
    }
    const char* cA = unitA(g, cur); const char* cB = unitB(g, cur);
    PG8_STAGE(PG8_SB(0, 0), cB, voffB); PG8_STAGE(PG8_SB(0, 1), cB + hstepB, voffB); PG8_STAGE(PG8_SA(0, 0), cA, voffA); PG8_STAGE(PG8_SA(0, 1), cA + hstepA, voffA);
    if (wr == 1) PG8_BAR;
    PG8_WAIT_V(2); PG8_BAR;
    PG8_STAGE(PG8_SB(1, 0), cB + kstep, voffB); PG8_STAGE(PG8_SA(1, 0), cA + kstep, voffA); PG8_STAGE(PG8_SB(1, 1), cB + hstepB + kstep, voffB);
    PG8_WAIT_V(6); PG8_BAR;
    for (;;) {
        const bool has_next = S.next(ui + 1, nxt);
        const char* nA = has_next ? unitA(g, nxt) : cA; const char* nB = has_next ? unitB(g, nxt) : cB;
        for (int t = 0; t < nt; t += 2) {
            const bool last = (t == nt - 2);
            const char* a1 = cA + (size_t)(t + 1) * kstep;
            const char* a2 = last ? nA : cA + (size_t)(t + 2) * kstep; const char* b2 = last ? nB : cB + (size_t)(t + 2) * kstep;
            const char* a3 = a2 + kstep; const char* b3 = b2 + kstep;
            PG8_LDB(B0, 0, 0); PG8_LDB(B1, 0, 1); PG8_SCHED; PG8_LDA(At, 0, 0); PG8_STAGE(PG8_SA(1, 1), a1 + hstepA, voffA);
            PG8_WAIT_V(8); PG8_WAIT_L(0); PG8_BAR; PG8_MMA(0, 0, At, B0); PG8_MMA(0, 1, At, B1); PG8_BAR; PG8_SCHED;
            PG8_LDA(At, 0, 1); PG8_STAGE(PG8_SB(0, 0), b2, voffB); PG8_STAGE(PG8_SB(0, 1), b2 + hstepB, voffB); PG8_STAGE(PG8_SA(0, 0), a2, voffA);
            PG8_WAIT_V(8); PG8_WAIT_L(0); PG8_BAR; PG8_MMA(1, 0, At, B0); PG8_MMA(1, 1, At, B1); PG8_BAR; PG8_SCHED;
            PG8_LDB(B0, 1, 0); PG8_LDB(B1, 1, 1); PG8_SCHED; PG8_LDA(At, 1, 0); PG8_STAGE(PG8_SA(0, 1), a2 + hstepA, voffA);
            PG8_WAIT_V(8); PG8_WAIT_L(0); PG8_BAR; PG8_MMA(0, 0, At, B0); PG8_MMA(0, 1, At, B1); PG8_BAR; PG8_SCHED;
            PG8_LDA(At, 1, 1); PG8_STAGE(PG8_SB(1, 0), b3, voffB); PG8_STAGE(PG8_SB(1, 1), b3 + hstepB, voffB); PG8_STAGE(PG8_SA(1, 0), a3, voffA);
            PG8_WAIT_V(8); PG8_WAIT_L(0); PG8_BAR; PG8_MMA(1, 0, At, B0); PG8_MMA(1, 1, At, B1); PG8_BAR; PG8_SCHED;
        }
        if (wr == 0) PG8_BAR;
        E(acc, cur, wr, wc, fr, fq, scr);
        if (!has_next) break;
#pragma unroll
        for (int a = 0; a < 2; ++a)
#pragma unroll
            for (int b = 0; b < 2; ++b)
#pragma unroll
                for (int m = 0; m < 4; ++m)
#pragma unroll
                    for (int n = 0; n < 2; ++n) acc[a][b][m][n] = (f32x4){0.f, 0.f, 0.f, 0.f};
        cur = nxt; cA = nA; cB = nB; ++ui;
        if (wr == 1) PG8_BAR;
    }
    PG8_WAIT_V(0);
    PG8_BAR;
#undef PG8_SA
#undef PG8_SB
#undef PG8_STAGE
#undef PG8_LDA
#undef PG8_LDB
#undef PG8_MMA
#undef PG8_WAIT_V
#undef PG8_WAIT_L
#undef PG8_BAR
#undef PG8_SCHED
}

#define EPI_ARGS f32x4 (&acc)[2][2][4][2], const Unit& u, int wr, int wc, int fr, int fq, LAS unsigned char* scr
#define EPI_BAR() do { asm volatile("s_waitcnt lgkmcnt(0)" ::: "memory"); __builtin_amdgcn_s_barrier(); asm volatile("" ::: "memory"); } while (0)

struct EpiBf16 {
    static constexpr bool PERM = true;
    bf16* O; int ldc; const float* colscale; float scale; int zdiv; size_t sChi, sClo;
    __device__ __forceinline__ void operator()(EPI_ARGS) const {
        bf16* base = O + (size_t)(u.z / zdiv) * sChi + (size_t)(u.z % zdiv) * sClo;
        const int row0 = u.pm * BM + wr * 64 + fr, col0 = u.pn * BM + wc * 32 + 8 * fq;
        f32x4 cs[2][2];
#pragma unroll
        for (int bj = 0; bj < 2; ++bj)
#pragma unroll
            for (int n = 0; n < 2; ++n) { cs[bj][n] = colscale ? *(const f32x4*)(colscale + col0 + bj * HALF + 4 * n) : (f32x4){1.f, 1.f, 1.f, 1.f}; cs[bj][n] = cs[bj][n] * scale; }
#pragma unroll
        for (int ai = 0; ai < 2; ++ai)
#pragma unroll
            for (int m = 0; m < 4; ++m) { bf16* rowp = base + (size_t)(row0 + ai * HALF + m * 16) * ldc + col0;
#pragma unroll
                for (int bj = 0; bj < 2; ++bj) { const f32x4 v0 = acc[ai][bj][m][0] * cs[bj][0], v1 = acc[ai][bj][m][1] * cs[bj][1];
                    u32x4 w; w.x = cvt_pk_bf16(v0[0], v0[1]); w.y = cvt_pk_bf16(v0[2], v0[3]); w.z = cvt_pk_bf16(v1[0], v1[1]); w.w = cvt_pk_bf16(v1[2], v1[3]);
                    *(u32x4*)(rowp + bj * HALF) = w; } }
    }
};

template <bool I8> struct EpiProj {
    static constexpr bool PERM = true;
    bf16 *U0, *CH, *BG; int pn_off; const float* sA; const unsigned* cmaxB; LAS float* rtab;
    __device__ __forceinline__ void operator()(EPI_ARGS) const {
        const int row0 = u.pm * BM + wr * 64 + fr, c8 = wc * 32 + 8 * fq, pn = u.pn + pn_off;
        if (I8) { if (__builtin_amdgcn_readfirstlane(((LAS int*)rtab)[256]) != u.pm) { EPI_BAR(); if (threadIdx.x < 256) rtab[threadIdx.x] = sA[u.pm * BM + threadIdx.x]; if (threadIdx.x == 0) ((LAS int*)rtab)[256] = u.pm; EPI_BAR(); } }
        if (I8 || pn < 32) {
            const bool glu = I8 || pn < 16;
            bf16* base = (glu ? U0 : CH) + (size_t)((pn & 15) * HALF + c8);
            f32x4 sb[2][2];
            if (I8) {
#pragma unroll
                for (int bj = 0; bj < 2; ++bj)
#pragma unroll
                    for (int n = 0; n < 2; ++n) { const u32x4 cm = *(const u32x4*)(cmaxB + pn * BM + bj * HALF + c8 + 4 * n); sb[bj][n] = (f32x4){__uint_as_float(cm.x), __uint_as_float(cm.y), __uint_as_float(cm.z), __uint_as_float(cm.w)} * (1.0f / 127.0f); } }
#pragma unroll
            for (int ai = 0; ai < 2; ++ai)
#pragma unroll
                for (int m = 0; m < 4; ++m) {
                    const float rs = I8 ? rtab[wr * 64 + fr + ai * HALF + m * 16] : 1.0f;
                    f32x4 o[2];
#pragma unroll
                    for (int n = 0; n < 2; ++n) { f32x4 a = acc[ai][0][m][n], b = acc[ai][1][m][n];
                        if (I8) { const i32x4 ia = __builtin_bit_cast(i32x4, a), ib = __builtin_bit_cast(i32x4, b);
                            a = (f32x4){(float)ia[0], (float)ia[1], (float)ia[2], (float)ia[3]} * (sb[0][n] * rs); b = (f32x4){(float)ib[0], (float)ib[1], (float)ib[2], (float)ib[3]} * (sb[1][n] * rs); }
#pragma unroll
                        for (int e = 0; e < 4; ++e) o[n][e] = glu ? a[e] * fast_sigmoid(b[e]) : a[e] * b[e]; }
                    u32x4 w; w.x = cvt_pk_bf16(o[0][0], o[0][1]); w.y = cvt_pk_bf16(o[0][2], o[0][3]); w.z = cvt_pk_bf16(o[1][0], o[1][1]); w.w = cvt_pk_bf16(o[1][2], o[1][3]);
                    *(u32x4*)(base + (size_t)(row0 + ai * HALF + m * 16) * CWID) = w; }
        } else {
            bf16* base = BG + (size_t)((pn - 32) * BM + c8);
#pragma unroll
            for (int ai = 0; ai < 2; ++ai)
#pragma unroll
                for (int m = 0; m < 4; ++m)
#pragma unroll
                    for (int bj = 0; bj < 2; ++bj) { const f32x4 v0 = acc[ai][bj][m][0], v1 = acc[ai][bj][m][1];
                        u32x4 w; w.x = cvt_pk_bf16(v0[0], v0[1]); w.y = cvt_pk_bf16(v0[2], v0[3]); w.z = cvt_pk_bf16(v1[0], v1[1]); w.w = cvt_pk_bf16(v1[2], v1[3]);
                        *(u32x4*)(base + (size_t)(row0 + ai * HALF + m * 16) * CWID + bj * HALF) = w; }
        }
    }
};

template <bool RES_BF16> struct EpiResid {
    static constexpr bool PERM = true;
    const void* resid; bf16* ob; float* rowsq; unsigned* rowmax; int ldc;
    __device__ __forceinline__ void operator()(EPI_ARGS) const {
        const int row0 = u.pm * BM + wr * 64 + fr, col0 = u.pn * BM + wc * 32 + 8 * fq;
        float ssv[8], mxv[8];
#pragma unroll
        for (int ai = 0; ai < 2; ++ai) {
            f32x4 r0[4][2], r1[4][2];
#pragma unroll
            for (int m = 0; m < 4; ++m)
#pragma unroll
                for (int bj = 0; bj < 2; ++bj) { const size_t off = (size_t)(row0 + ai * HALF + m * 16) * ldc + col0 + bj * HALF;
                    if (RES_BF16) { const u32x4 rw = *(const u32x4*)((const bf16*)resid + off); r0[m][bj] = __builtin_bit_cast(f32x4, rw); }
                    else { r0[m][bj] = *(const f32x4*)((const float*)resid + off); r1[m][bj] = *(const f32x4*)((const float*)resid + off + 4); } }
#pragma unroll
            for (int m = 0; m < 4; ++m) { const int row = row0 + ai * HALF + m * 16; const size_t off = (size_t)row * ldc + col0; float ss = 0.f, mx = 0.f;
#pragma unroll
                for (int bj = 0; bj < 2; ++bj) {
                    f32x4 a0, a1;
                    if (RES_BF16) { const u32x4 rw = __builtin_bit_cast(u32x4, r0[m][bj]); a0 = (f32x4){bf_lo(rw.x), bf_hi(rw.x), bf_lo(rw.y), bf_hi(rw.y)}; a1 = (f32x4){bf_lo(rw.z), bf_hi(rw.z), bf_lo(rw.w), bf_hi(rw.w)}; }
                    else { a0 = r0[m][bj]; a1 = r1[m][bj]; }
                    const f32x4 v0 = acc[ai][bj][m][0] + a0, v1 = acc[ai][bj][m][1] + a1;
                    u32x4 w; w.x = cvt_pk_bf16(v0[0], v0[1]); w.y = cvt_pk_bf16(v0[2], v0[3]); w.z = cvt_pk_bf16(v1[0], v1[1]); w.w = cvt_pk_bf16(v1[2], v1[3]); *(u32x4*)(ob + off + bj * HALF) = w;
                    ss += (v0[0] * v0[0] + v0[1] * v0[1]) + (v0[2] * v0[2] + v0[3] * v0[3]) + (v1[0] * v1[0] + v1[1] * v1[1]) + (v1[2] * v1[2] + v1[3] * v1[3]);
                    if (rowmax) mx = fmaxf(mx, fmaxf(fmaxf(fmaxf(fabsf(v0[0]), fabsf(v0[1])), fmaxf(fabsf(v0[2]), fabsf(v0[3]))), fmaxf(fmaxf(fabsf(v1[0]), fabsf(v1[1])), fmaxf(fabsf(v1[2]), fabsf(v1[3]))))); }
                ss += __shfl_xor(ss, 16); ss += __shfl_xor(ss, 32); ssv[ai * 4 + m] = ss;
                if (rowmax) { mx = fmaxf(mx, __shfl_xor(mx, 16)); mx = fmaxf(mx, __shfl_xor(mx, 32)); } mxv[ai * 4 + m] = mx; }
            asm volatile("" ::: "memory"); }
        float s0 = 0.f, s1 = 0.f, m0 = 0.f, m1 = 0.f;
#pragma unroll
        for (int k = 0; k < 8; ++k) if ((k >> 1) == fq) { if (k & 1) { s1 = ssv[k]; m1 = mxv[k]; } else { s0 = ssv[k]; m0 = mxv[k]; } }
        const int rq = row0 + (fq >> 1) * HALF + (fq & 1) * 32;
        __hip_atomic_fetch_add(rowsq + rq, s0, __ATOMIC_RELAXED, __HIP_MEMORY_SCOPE_AGENT); __hip_atomic_fetch_add(rowsq + rq + 16, s1, __ATOMIC_RELAXED, __HIP_MEMORY_SCOPE_AGENT);
        if (rowmax) { __hip_atomic_fetch_max(rowmax + rq, __float_as_uint(m0), __ATOMIC_RELAXED, __HIP_MEMORY_SCOPE_AGENT); __hip_atomic_fetch_max(rowmax + rq + 16, __float_as_uint(m1), __ATOMIC_RELAXED, __HIP_MEMORY_SCOPE_AGENT); }
    }
};

__device__ __forceinline__ float row_rstd(const float* rowsq, int row) { return 1.0f / sqrtf(__hip_atomic_load(rowsq + row, __ATOMIC_RELAXED, __HIP_MEMORY_SCOPE_AGENT) * (1.0f / DM) + EPS); }

struct EpiSoftmax {
    static constexpr bool PERM = true;
    bf16* P; const float* rowsq; int ldc;
    __device__ __forceinline__ void operator()(EPI_ARGS) const {
        LAS float* RM = (LAS float*)scr;
        LAS float* RS = RM + 1024;
        const int rl0 = wr * 64 + fr;
#pragma unroll
        for (int ai = 0; ai < 2; ++ai)
#pragma unroll
            for (int m = 0; m < 4; ++m) { const int rl = rl0 + ai * HALF + m * 16; const float rs = row_rstd(rowsq, u.pm * BM + rl); float mx = -3.0e38f;
#pragma unroll
                for (int bj = 0; bj < 2; ++bj)
#pragma unroll
                    for (int n = 0; n < 2; ++n) { acc[ai][bj][m][n] = acc[ai][bj][m][n] * rs; const f32x4 v = acc[ai][bj][m][n]; mx = fmaxf(mx, fmaxf(fmaxf(v[0], v[1]), fmaxf(v[2], v[3]))); }
                mx = fmaxf(mx, __shfl_xor(mx, 16)); mx = fmaxf(mx, __shfl_xor(mx, 32));
                if (fq == 0) RM[rl * 4 + wc] = mx; }
        EPI_BAR();
#pragma unroll
        for (int ai = 0; ai < 2; ++ai)
#pragma unroll
            for (int m = 0; m < 4; ++m) { const int rl = rl0 + ai * HALF + m * 16; const f32x4 m4 = *(const LAS f32x4*)(RM + rl * 4); const float mx = fmaxf(fmaxf(m4[0], m4[1]), fmaxf(m4[2], m4[3])); float sm = 0.f;
#pragma unroll
                for (int bj = 0; bj < 2; ++bj)
#pragma unroll
                    for (int n = 0; n < 2; ++n) { f32x4 v = acc[ai][bj][m][n];
#pragma unroll
                        for (int e = 0; e < 4; ++e) { v[e] = __builtin_amdgcn_exp2f(v[e] - mx); sm += v[e]; }
                        acc[ai][bj][m][n] = v; }
                sm += __shfl_xor(sm, 16); sm += __shfl_xor(sm, 32);
                if (fq == 0) RS[rl * 4 + wc] = sm; }
        EPI_BAR();
        const int row0 = u.pm * BM + rl0, col0 = u.pn * BM + wc * 32 + 8 * fq;
#pragma unroll
        for (int ai = 0; ai < 2; ++ai)
#pragma unroll
            for (int m = 0; m < 4; ++m) { const int rl = rl0 + ai * HALF + m * 16; const f32x4 s4 = *(const LAS f32x4*)(RS + rl * 4); const float inv = 1.0f / ((s4[0] + s4[1]) + (s4[2] + s4[3]));
                bf16* rowp = P + (size_t)(row0 + ai * HALF + m * 16) * ldc + col0;
#pragma unroll
                for (int bj = 0; bj < 2; ++bj) { const f32x4 v0 = acc[ai][bj][m][0] * inv, v1 = acc[ai][bj][m][1] * inv;
                    u32x4 w; w.x = cvt_pk_bf16(v0[0], v0[1]); w.y = cvt_pk_bf16(v0[2], v0[3]); w.z = cvt_pk_bf16(v1[0], v1[1]); w.w = cvt_pk_bf16(v1[2], v1[3]);
                    *(u32x4*)(rowp + bj * HALF) = w; } }
        EPI_BAR();
    }
};

template <bool I8, int NREP = 1> struct EpiGateUp {
    static constexpr bool PERM = true;
    bf16* F; const float* rowsq; const float* cw; float* tailG; float* headG; float* headU; const unsigned* rowmaxA; const unsigned* colmaxB; LAS float* rtab;
    __device__ __forceinline__ void operator()(EPI_ARGS) const {
        LAS float* H = (LAS float*)scr;
        if (__builtin_amdgcn_readfirstlane(((LAS int*)rtab)[256]) != u.pm) { EPI_BAR();
            if (threadIdx.x < 256) { const int row = u.pm * BM + threadIdx.x; float rs = row_rstd(rowsq, row); if (I8) rs *= __uint_as_float(__hip_atomic_load(rowmaxA + row, __ATOMIC_RELAXED, __HIP_MEMORY_SCOPE_AGENT)) * (1.0f / 127.0f); rtab[threadIdx.x] = rs; }
            if (threadIdx.x == 0) ((LAS int*)rtab)[256] = u.pm; EPI_BAR(); }
        const int c8 = wc * 32 + 8 * fq, j8 = u.pn * HALF + c8;
        f32x4 w0[2], w1[2], w2[2];
#pragma unroll
        for (int n = 0; n < 2; ++n) { w0[n] = *(const f32x4*)(cw + j8 + 4 * n); w1[n] = *(const f32x4*)(cw + FF + j8 + 4 * n); w2[n] = *(const f32x4*)(cw + 2 * FF + j8 + 4 * n); }
        f32x4 sb[2][2];
        if (I8) {
#pragma unroll
            for (int bj = 0; bj < 2; ++bj)
#pragma unroll
                for (int n = 0; n < 2; ++n) { const u32x4 cm = *(const u32x4*)(colmaxB + u.pn * BM + bj * HALF + c8 + 4 * n); sb[bj][n] = (f32x4){__uint_as_float(cm.x), __uint_as_float(cm.y), __uint_as_float(cm.z), __uint_as_float(cm.w)} * (1.0f / 127.0f); } }
#pragma unroll
        for (int ai = 0; ai < 2; ++ai)
#pragma unroll
            for (int m = 0; m < 4; ++m) { const int rl = ai * HALF + wr * 64 + m * 16 + fr; const float rs = rtab[rl];
#pragma unroll
                for (int bj = 0; bj < 2; ++bj)
#pragma unroll
                    for (int n = 0; n < 2; ++n) {
                        if (I8) { const i32x4 iv = __builtin_bit_cast(i32x4, acc[ai][bj][m][n]); acc[ai][bj][m][n] = (f32x4){(float)iv[0], (float)iv[1], (float)iv[2], (float)iv[3]} * (sb[bj][n] * rs); }
                        else acc[ai][bj][m][n] = acc[ai][bj][m][n] * rs; } }
#pragma unroll
        for (int rp_ = 0; rp_ < NREP; ++rp_) {
        if (fr >= 14) {
#pragma unroll
            for (int ai = 0; ai < 2; ++ai)
#pragma unroll
                for (int n = 0; n < 2; ++n) *(LAS f32x4*)(H + (((2 * ai + wr) * 2 + (fr - 14)) * HALF + c8 + 4 * n)) = acc[ai][0][3][n];
            if (wr == 1) {
#pragma unroll
                for (int n = 0; n < 2; ++n) *(f32x4*)(tailG + ((size_t)(u.pm * 2 + (fr - 14)) * FF + j8 + 4 * n)) = acc[1][0][3][n]; }
        }
        if (wr == 0 && fr < 2) {
#pragma unroll
            for (int n = 0; n < 2; ++n) { *(f32x4*)(headG + ((size_t)(u.pm * 2 + fr) * FF + j8 + 4 * n)) = acc[0][0][0][n]; *(f32x4*)(headU + ((size_t)(u.pm * 2 + fr) * FF + j8 + 4 * n)) = acc[0][1][0][n]; } }
        EPI_BAR();
#pragma unroll
        for (int ai = 0; ai < 2; ++ai) {
            const int rb = 2 * ai + wr;
            f32x4 py1[2], py0[2];
#pragma unroll
            for (int n = 0; n < 2; ++n) { py1[n] = (f32x4){0.f, 0.f, 0.f, 0.f}; py0[n] = py1[n]; }
#pragma unroll
            for (int m = 0; m < 4; ++m) {
                f32x4 o[2];
#pragma unroll
                for (int n = 0; n < 2; ++n) {
                    const f32x4 x = acc[ai][0][m][n], up = acc[ai][1][m][n];
                    f32x4 ht = (f32x4){0.f, 0.f, 0.f, 0.f};
                    if (m == 0) { const int hb = rb > 0 ? rb - 1 : 0; const float hz = rb > 0 ? 1.f : 0.f, s0 = (fr == 0) ? hz : 0.f, s1 = (fr == 1) ? hz : 0.f;
                        const f32x4 h62 = *(const LAS f32x4*)(H + ((hb * 2 + 0) * HALF + c8 + 4 * n)), h63 = *(const LAS f32x4*)(H + ((hb * 2 + 1) * HALF + c8 + 4 * n));
#pragma unroll
                        for (int e = 0; e < 4; ++e) ht[e] = s0 * (w1[n][e] * h63[e] + w0[n][e] * h62[e]) + s1 * (w0[n][e] * h63[e]); }
                    const f32x4 y1 = x * w1[n], y0 = x * w0[n];
#pragma unroll
                    for (int e = 0; e < 4; ++e) {
                        float gg = w2[n][e] * x[e];
                        gg += dpp_shr<1>(y1[e]);
                        gg += dpp_shr<2>(y0[e]);
                        if (m > 0) { gg += dpp_shl<15>(py1[n][e]); gg += dpp_shl<14>(py0[n][e]); }
                        else gg += ht[e];
                        o[n][e] = gg * fast_sigmoid(gg) * up[e];
                    }
                    py1[n] = y1; py0[n] = y0; }
                u32x4 w; w.x = cvt_pk_bf16(o[0][0], o[0][1]); w.y = cvt_pk_bf16(o[0][2], o[0][3]); w.z = cvt_pk_bf16(o[1][0], o[1][1]); w.w = cvt_pk_bf16(o[1][2], o[1][3]);
                *(u32x4*)(F + (size_t)(u.pm * BM + ai * HALF + wr * 64 + m * 16 + fr) * FF + j8) = w;
            } }
        EPI_BAR(); }
    }
};
}

constexpr size_t MiB = 1u << 20;
constexpr size_t WS_CTL = 0, CTL_ZERO_BYTES = 1 * MiB;
constexpr size_t WS_WIN = 1 * MiB;
constexpr size_t WS_XN = WS_WIN + 80 * MiB;
constexpr size_t WS_WOUT = WS_XN + 128 * MiB;
constexpr size_t WS_WKV = WS_WOUT + 32 * MiB;
constexpr size_t WS_WQ = WS_WKV + 64 * MiB;
constexpr size_t WS_WO = WS_WQ + 32 * MiB;
constexpr size_t WS_F = WS_WIN;
constexpr size_t WS_WGU = WS_WO + 32 * MiB;
constexpr size_t WS_A8 = WS_WGU + 86 * MiB;
constexpr size_t WS_WDN = WS_A8 + 64 * MiB;
constexpr size_t WS_MEMN = WS_WDN + 86 * MiB;
constexpr size_t WS_KV = WS_MEMN + 8 * MiB;
constexpr size_t WS_WQK = WS_KV + 16 * MiB;
constexpr size_t WS_VWO = WS_WQK + 32 * MiB;
constexpr size_t WS_HB = WS_VWO + 32 * MiB;
constexpr size_t WS_P = WS_HB + 128 * MiB;
constexpr size_t WS_WIN8 = WS_P + 32 * MiB;
constexpr size_t WS_XN8 = WS_WIN8 + 16 * MiB;
constexpr size_t WS_SA1 = WS_XN8 + 64 * MiB;
constexpr size_t WS_HALO = WS_SA1 + 1 * MiB;
constexpr size_t HALO_ONE = (size_t)64 * 2 * FF * 4;
constexpr size_t WS_END = WS_HALO + 18 * MiB;
static_assert(WS_F + (size_t)MTOK * FF * 2 <= WS_WGU, "F overlay");
static_assert(3 * HALO_ONE <= 18 * MiB, "halo");
constexpr int CW_BAR = 4096;
constexpr int CW_RSQ1 = 65536, CW_RSQ2 = CW_RSQ1 + MTOK, CW_RSQ3 = CW_RSQ2 + MTOK;
constexpr int CW_CMAX = CW_RSQ3 + MTOK;
constexpr int CW_RMAX = CW_CMAX + 2 * FF;
constexpr int CW_CMAX1 = CW_RMAX + MTOK;
static_assert((size_t)(CW_CMAX1 + 4096) * 4 <= CTL_ZERO_BYTES, "ctl");

constexpr int RING_OFF = 0, RING_BYTES = 131072;
constexpr int SCR_OFF = RING_BYTES;
constexpr int LDS_BYTES = 147456;
constexpr int MISC_OFF = LDS_BYTES - 128;
constexpr int NWAVES = 8;

#define XB_TMO      128
#define XB_XCNT(j)  (256  + 64 * (j))
#define XB_XSUB(j)  (1280 + 64 * (j))
#define XB_XGEN(j)  (2304 + 64 * (j))
#define XB_TOP      3328
#define XB_TOPGEN   3392
#define XCD_BAR_WORDS 3456
#define XB_SPIN_CAP (1u << 22)

__device__ __forceinline__ unsigned xb_ld(unsigned* p)              { return __hip_atomic_load(p, __ATOMIC_RELAXED, __HIP_MEMORY_SCOPE_AGENT); }
__device__ __forceinline__ unsigned xb_add(unsigned* p, unsigned v) { return __hip_atomic_fetch_add(p, v, __ATOMIC_RELAXED, __HIP_MEMORY_SCOPE_AGENT); }
__device__ __forceinline__ unsigned xb_xcc_id() { return (unsigned)__builtin_amdgcn_s_getreg((3 << 11) | 20) & 0xFu; }
#define XB_SPIN(cond, bar) do { unsigned _sp = 0; while (cond) { __builtin_amdgcn_s_sleep(1); \
    if ((++_sp & 255u) == 0u) { if (xb_ld(&(bar)[XB_TMO])) break; if (_sp > XB_SPIN_CAP) { atomicAdd(&(bar)[XB_TMO], 1u); break; } } } } while (0)

struct XcdBarrier { unsigned* bar; unsigned x; volatile LAS unsigned* st; };

__device__ __forceinline__ XcdBarrier xcd_barrier_post(unsigned* bar, volatile LAS unsigned* st) {
    XcdBarrier b; b.bar = bar; b.x = xb_xcc_id(); b.st = st;
    if (threadIdx.x == 0) (void)xb_add(&bar[XB_XCNT(b.x)], 1u);
    return b;
}
__device__ __forceinline__ void xcd_barrier_complete(unsigned* bar, unsigned x, unsigned& nloc, unsigned& nx) {
    const unsigned G = gridDim.x * gridDim.y * gridDim.z;
    unsigned sum, cnt, mine, sp = 0u;
    for (;;) {
        sum = 0u; cnt = 0u; mine = 0u;
#pragma unroll
        for (unsigned j = 0; j < 16; ++j) { const unsigned c = xb_ld(&bar[XB_XCNT(j)]); sum += c; cnt += (c > 0u) ? 1u : 0u; mine = (j == x) ? c : mine; }
        if (sum == G) break;
        __builtin_amdgcn_s_sleep(1);
        if ((++sp & 255u) == 0u) { if (xb_ld(&bar[XB_TMO])) break; if (sp > XB_SPIN_CAP) { atomicAdd(&bar[XB_TMO], 1u); break; } }
    }
    nloc = mine > 0u ? mine : 1u; nx = cnt > 0u ? cnt : 1u;
}
__device__ __forceinline__ void xcd_barrier(const XcdBarrier& b) {
    asm volatile("s_waitcnt vmcnt(0)" ::: "memory");
    __syncthreads();
    if (threadIdx.x == 0) {
        unsigned* bar = b.bar;
        __builtin_amdgcn_s_waitcnt(0);
        unsigned nloc = b.st[0], nx = b.st[1];
        if (nloc == 0u) { xcd_barrier_complete(bar, b.x, nloc, nx); b.st[0] = nloc; b.st[1] = nx; }
        const unsigned old = xb_add(&bar[XB_XSUB(b.x)], 1u);
        const unsigned gen = old / nloc;
        if (old + 1u == (gen + 1u) * nloc) {
            __builtin_amdgcn_fence(__ATOMIC_RELEASE, "agent");
            asm volatile("s_waitcnt vmcnt(0)" ::: "memory");
            const unsigned og = xb_add(&bar[XB_TOP], 1u);
            const unsigned tg = og / nx;
            if (og + 1u == (tg + 1u) * nx) xb_add(&bar[XB_TOPGEN], 1u);
            else XB_SPIN(xb_ld(&bar[XB_TOPGEN]) == tg, bar);
            __builtin_amdgcn_fence(__ATOMIC_ACQUIRE, "agent");
            xb_add(&bar[XB_XGEN(b.x)], 1u);
            asm volatile("s_waitcnt vmcnt(0)" ::: "memory");
        } else {
            XB_SPIN(xb_ld(&bar[XB_XGEN(b.x)]) == gen, bar);
            __builtin_amdgcn_fence(__ATOMIC_ACQUIRE, "agent");
            asm volatile("s_waitcnt vmcnt(0)" ::: "memory");
        }
    }
    __syncthreads();
}

#define LDS_WAIT() asm volatile("s_waitcnt lgkmcnt(0)" ::: "memory")

template <int MAP> __device__ __forceinline__ int rowmap(int n, int row_off) {
    if (MAP == 0) return row_off + n;
    if (MAP == 2) return 256 * (n >> 7) + (n & 127);
    if (MAP == 3) return 256 * (n >> 7) + 128 + (n & 127);
    const int seg = n >> 11, j = n & 2047;
    if (seg == 0) return 256 * (j >> 7) + (j & 127);
    if (seg == 1) return 256 * (j >> 7) + 128 + (j & 127);
    if (seg == 2) return 8192 + j;
    if (seg == 3) return 4096 + 256 * (j >> 7) + (j & 127);
    return 4096 + 256 * (j >> 7) + 128 + (j & 127);
}
template <int MAP> __device__ __forceinline__ void transpose_item(const float* W, int K, int N, bf16* WT, int row_off, const float* gk, LAS float* scr, int item, int lane) {
    const int nblk = N / 64, kb = item / nblk, nb = item % nblk, k0 = 64 * kb, n0 = 64 * nb;
    const int n4 = lane & 15, kr = lane >> 4;
    f32x4 v[16];
#pragma unroll
    for (int i = 0; i < 16; ++i) v[i] = *(const GAS f32x4*)(W + (size_t)(k0 + 4 * i + kr) * N + n0 + 4 * n4);
    if (gk) {
#pragma unroll
        for (int i = 0; i < 16; ++i) v[i] = v[i] * gk[k0 + 4 * i + kr]; }
#pragma unroll
    for (int i = 0; i < 16; ++i) { LAS float* d = scr + (4 * i + kr) * 65 + 4 * n4; d[0] = v[i][0]; d[1] = v[i][1]; d[2] = v[i][2]; d[3] = v[i][3]; }
    LDS_WAIT(); asm volatile("" ::: "memory");
    const int c = lane & 7, nn = lane >> 3;
#pragma unroll
    for (int j = 0; j < 8; ++j) { const int n = nn + 8 * j; const LAS float* s = scr + (8 * c) * 65 + n;
        u32x4 o; o.x = cvt_pk_bf16(s[0 * 65], s[1 * 65]); o.y = cvt_pk_bf16(s[2 * 65], s[3 * 65]); o.z = cvt_pk_bf16(s[4 * 65], s[5 * 65]); o.w = cvt_pk_bf16(s[6 * 65], s[7 * 65]);
        *(GAS u32x4*)(WT + (size_t)rowmap<MAP>(n0 + n, row_off) * K + k0 + 8 * c) = o; }
    LDS_WAIT(); asm volatile("" ::: "memory");
}
__device__ __forceinline__ unsigned pack4_i8(int a, int b, int c, int d) { return (unsigned)(a & 0xff) | ((unsigned)(b & 0xff) << 8) | ((unsigned)(c & 0xff) << 16) | ((unsigned)d << 24); }
__device__ __forceinline__ int quant_i8(float x, float inv) { return (int)fminf(fmaxf(__builtin_rintf(x * inv), -127.0f), 127.0f); }
template <int MAP> __device__ __forceinline__ void colmax_item(const float* W, int N, const float* gk, unsigned* cmax, int item, int lane) {
    const int nblk = N / 256, kb = item / nblk, nb = item % nblk, k0 = 64 * kb, n0 = 256 * nb + 4 * lane;
    f32x4 mx = (f32x4){0.f, 0.f, 0.f, 0.f};
#pragma unroll 16
    for (int k = 0; k < 64; ++k) { const f32x4 v = *(const GAS f32x4*)(W + (size_t)(k0 + k) * N + n0) * (gk ? gk[k0 + k] : 1.0f);
        mx[0] = fmaxf(mx[0], fabsf(v[0])); mx[1] = fmaxf(mx[1], fabsf(v[1])); mx[2] = fmaxf(mx[2], fabsf(v[2])); mx[3] = fmaxf(mx[3], fabsf(v[3])); }
#pragma unroll
    for (int e = 0; e < 4; ++e) __hip_atomic_fetch_max(cmax + rowmap<MAP>(n0 + e, 0), __float_as_uint(mx[e]), __ATOMIC_RELAXED, __HIP_MEMORY_SCOPE_AGENT);
}
template <int MAP> __device__ __forceinline__ void quant_item(const float* W, int K, int N, unsigned char* W8, const float* gk, const unsigned* cmax, LAS float* scr, int item, int lane) {
    const int nblk = N / 32, kb = item / nblk, nb = item % nblk, k0 = 128 * kb, n0 = 32 * nb;
    const int n4 = lane & 7, kr = lane >> 3;
    f32x4 v[16];
#pragma unroll
    for (int i = 0; i < 16; ++i) v[i] = *(const GAS f32x4*)(W + (size_t)(k0 + 8 * i + kr) * N + n0 + 4 * n4);
#pragma unroll
    for (int i = 0; i < 16; ++i) v[i] = v[i] * (gk ? gk[k0 + 8 * i + kr] : 1.0f);
#pragma unroll
    for (int i = 0; i < 16; ++i) { LAS float* d = scr + (8 * i + kr) * 33 + 4 * n4; d[0] = v[i][0]; d[1] = v[i][1]; d[2] = v[i][2]; d[3] = v[i][3]; }
    LDS_WAIT(); asm volatile("" ::: "memory");
    const int c = lane & 7, nn = lane >> 3;
#pragma unroll
    for (int j = 0; j < 4; ++j) { const int n = nn + 8 * j, dr = rowmap<MAP>(n0 + n, 0); const float cm = __uint_as_float(__hip_atomic_load(cmax + dr, __ATOMIC_RELAXED, __HIP_MEMORY_SCOPE_AGENT)); const float inv = cm > 0.f ? 127.0f / cm : 0.f;
        const LAS float* sp = scr + (16 * c) * 33 + n; int q[16];
#pragma unroll
        for (int t = 0; t < 16; ++t) q[t] = quant_i8(sp[t * 33], inv);
        u32x4 o; o.x = pack4_i8(q[0], q[1], q[2], q[3]); o.y = pack4_i8(q[4], q[5], q[6], q[7]); o.z = pack4_i8(q[8], q[9], q[10], q[11]); o.w = pack4_i8(q[12], q[13], q[14], q[15]);
        *(GAS u32x4*)(W8 + (size_t)dr * K + k0 + 16 * c) = o; }
    LDS_WAIT(); asm volatile("" ::: "memory");
}
__device__ __forceinline__ void quant_row_i8(const bf16* hrow, unsigned char* qrow, float amax, int lane) {
    const float inv = amax > 0.f ? 127.0f / amax : 0.f;
#pragma unroll
    for (int it = 0; it < 4; ++it) { const GAS u32x4* src = (const GAS u32x4*)(hrow + it * 1024 + lane * 16); const u32x4 a = src[0], b = src[1];
        u32x4 o;
        o.x = pack4_i8(quant_i8(bf_lo(a.x), inv), quant_i8(bf_hi(a.x), inv), quant_i8(bf_lo(a.y), inv), quant_i8(bf_hi(a.y), inv));
        o.y = pack4_i8(quant_i8(bf_lo(a.z), inv), quant_i8(bf_hi(a.z), inv), quant_i8(bf_lo(a.w), inv), quant_i8(bf_hi(a.w), inv));
        o.z = pack4_i8(quant_i8(bf_lo(b.x), inv), quant_i8(bf_hi(b.x), inv), quant_i8(bf_lo(b.y), inv), quant_i8(bf_hi(b.y), inv));
        o.w = pack4_i8(quant_i8(bf_lo(b.z), inv), quant_i8(bf_hi(b.z), inv), quant_i8(bf_lo(b.w), inv), quant_i8(bf_hi(b.w), inv));
        *(GAS u32x4*)(qrow + it * 1024 + lane * 16) = o; }
}
template <bool Q8> __device__ __forceinline__ void rms_rows(const float* X, const float* gain, bf16* O, unsigned char* Q, float* qs, int nrows, int m0, int mstep, int lane) {
    if (m0 >= nrows) return;
    f32x4 v[16];
#pragma unroll
    for (int j = 0; j < 16; ++j) v[j] = *((const GAS f32x4*)(X + (size_t)m0 * DM) + lane + 64 * j);
    for (int m = m0; m < nrows; m += mstep) {
        const int mn = (m + mstep < nrows) ? m + mstep : m;
        f32x4 nv[16];
#pragma unroll
        for (int j = 0; j < 16; ++j) nv[j] = *((const GAS f32x4*)(X + (size_t)mn * DM) + lane + 64 * j);
        float s = 0.f;
#pragma unroll
        for (int j = 0; j < 16; ++j) s += (v[j][0] * v[j][0] + v[j][1] * v[j][1]) + (v[j][2] * v[j][2] + v[j][3] * v[j][3]);
        const float rstd = 1.0f / sqrtf(wave_sum(s) * (1.0f / DM) + EPS);
        GAS u32x2* o8 = (GAS u32x2*)(O + (size_t)m * DM) + lane; float mx = 0.f;
#pragma unroll
        for (int j = 0; j < 16; ++j) { v[j] = v[j] * rstd * *((const GAS f32x4*)gain + lane + 64 * j); u32x2 w; w.x = cvt_pk_bf16(v[j][0], v[j][1]); w.y = cvt_pk_bf16(v[j][2], v[j][3]); o8[64 * j] = w;
            if (Q8) mx = fmaxf(mx, fmaxf(fmaxf(fabsf(v[j][0]), fabsf(v[j][1])), fmaxf(fabsf(v[j][2]), fabsf(v[j][3])))); }
        if (Q8) {
#pragma unroll
            for (int o = 1; o < 64; o <<= 1) mx = fmaxf(mx, __shfl_xor(mx, o));
            const float inv = mx > 0.f ? 127.0f / mx : 0.f;
            GAS unsigned* q4 = (GAS unsigned*)(Q + (size_t)m * DM) + lane;
#pragma unroll
            for (int j = 0; j < 16; ++j) q4[64 * j] = pack4_i8(quant_i8(v[j][0], inv), quant_i8(v[j][1], inv), quant_i8(v[j][2], inv), quant_i8(v[j][3], inv));
            if (lane == 0) qs[m] = mx * (1.0f / 127.0f);
        }
#pragma unroll
        for (int j = 0; j < 16; ++j) v[j] = nv[j];
    }
}

__device__ __forceinline__ void conv_a_wave(const bf16* U0, const float* cwp, const float* cb, const float* lg, const float* lb, bf16* MIX, LAS unsigned* T, int it0, int step, int nitems, int lane) {
    const int lr = lane >> 4, lc = lane & 15;
    int cur_grp = -1; f32x2 w[CONVK]; f32x2 bias = (f32x2){0.f, 0.f}, gg = bias, bb = bias;
#pragma unroll
    for (int k = 0; k < CONVK; ++k) w[k] = (f32x2){0.f, 0.f};
    for (int item = it0; item < nitems; item += step) {
        const int tb = item >> 4, grp = item & 15, r0 = tb * 32; const bool first = (r0 % SEQ) == 0;
        u32x4 v[16];
#pragma unroll
        for (int p = 0; p < 16; ++p) { const int rr = 4 * p + lr; v[p] = (u32x4){0u, 0u, 0u, 0u};
            if (rr < 62 && !(first && rr < 30)) v[p] = *(const GAS u32x4*)(U0 + (size_t)(r0 - 30 + rr) * CWID + grp * 128 + lc * 8); }
        if (grp != cur_grp) { cur_grp = grp;
#pragma unroll
            for (int k = 0; k < CONVK; ++k) w[k] = *(const GAS f32x2*)(cwp + k * CWID + grp * 128 + 2 * lane);
            bias = *(const GAS f32x2*)(cb + grp * 128 + 2 * lane); gg = *(const GAS f32x2*)(lg + grp * 128 + 2 * lane); bb = *(const GAS f32x2*)(lb + grp * 128 + 2 * lane); }
#pragma unroll
        for (int p = 0; p < 16; ++p) { const int rr = 4 * p + lr; if (rr < 62) *(LAS u32x4*)(T + rr * 64 + lc * 4) = v[p]; }
        LDS_WAIT(); asm volatile("" ::: "memory");
#pragma unroll
        for (int s = 0; s < 2; ++s) {
            float o0[16], o1[16];
#pragma unroll
            for (int j = 0; j < 16; ++j) { o0[j] = bias[0]; o1[j] = bias[1]; }
#pragma unroll
            for (int i = 0; i < 46; ++i) { const unsigned xw = T[(16 * s + i) * 64 + lane]; const float x0 = bf_lo(xw), x1 = bf_hi(xw);
#pragma unroll
                for (int j = 0; j < 16; ++j) { const int k = i - j; if (k >= 0 && k < CONVK) { o0[j] += w[k][0] * x0; o1[j] += w[k][1] * x1; } } }
#pragma unroll
            for (int j = 0; j < 16; ++j) {
                const float mu = wave_sum(o0[j] + o1[j]) * (1.0f / 128.0f); const float d0 = o0[j] - mu, d1 = o1[j] - mu;
                const float rstd = 1.0f / sqrtf(wave_sum(d0 * d0 + d1 * d1) * (1.0f / 128.0f) + EPS);
                const float y0 = d0 * rstd * gg[0] + bb[0], y1 = d1 * rstd * gg[1] + bb[1];
                *(GAS unsigned*)(MIX + (size_t)(r0 + 16 * s + j) * DM + grp * 128 + 2 * lane) = cvt_pk_bf16(y0 * fast_sigmoid(y0), y1 * fast_sigmoid(y1)); }
        }
        LDS_WAIT(); asm volatile("" ::: "memory");
    }
}

struct Args { const float* in[22]; float* out; unsigned char* ws; int ph_lo, ph_hi; };
constexpr int N_PHASES = 10;

__global__ void __launch_bounds__(NWAVES * 64, 2) fwd_kernel(Args args) {
    extern __shared__ __attribute__((aligned(16))) unsigned char lds_raw[];
    LAS unsigned char* lds = (LAS unsigned char*)lds_raw;
    volatile LAS unsigned* MISC = (volatile LAS unsigned*)(lds + MISC_OFF);
    const int tid = threadIdx.x, wave = __builtin_amdgcn_readfirstlane(tid >> 6);
#define lane ((int)(threadIdx.x & 63u))
    const int G = gridDim.x; const int bx = blockIdx.x; const int vcu = (G % 8 == 0) ? (bx % 8) * (G / 8) + bx / 8 : bx;
    unsigned char* ws = args.ws;
    gu32* ctl = (gu32*)(ws + WS_CTL);
    const float* x = args.in[0]; const float* mem = args.in[1]; const float* g_mix = args.in[2]; const float* w_in = args.in[3];
    const float* conv_a_w = args.in[4]; const float* conv_a_b = args.in[5]; const float* ln_a_g = args.in[6]; const float* ln_a_b = args.in[7];
    const float* conv_b_w = args.in[8]; const float* w_out = args.in[9]; const float* g_xattn = args.in[10]; const float* g_mem = args.in[11];
    const float* w_q = args.in[12]; const float* w_k = args.in[13]; const float* w_v = args.in[14]; const float* w_o = args.in[15];
    const float* g_ffn = args.in[16]; const float* w_gate = args.in[17]; const float* w_up = args.in[18]; const float* conv_f_w = args.in[19];
    const float* w_down = args.in[20]; const float* g_final = args.in[21];
    float* out = args.out;
    bf16* WIN = (bf16*)(ws + WS_WIN); bf16* XN = (bf16*)(ws + WS_XN); bf16* MIX = XN; bf16* WOUT = (bf16*)(ws + WS_WOUT); bf16* WKV = (bf16*)(ws + WS_WKV);
    bf16* WQ = (bf16*)(ws + WS_WQ); bf16* WO = (bf16*)(ws + WS_WO); bf16* FB = (bf16*)(ws + WS_F); unsigned char* WGU8 = ws + WS_WGU; unsigned char* A8 = ws + WS_A8; unsigned char* WIN8 = ws + WS_WIN8; unsigned char* XN8 = ws + WS_XN8; float* sA1 = (float*)(ws + WS_SA1); bf16* WDN = (bf16*)(ws + WS_WDN);
    bf16* MEMN = (bf16*)(ws + WS_MEMN); bf16* KV = (bf16*)(ws + WS_KV); bf16* WQK = (bf16*)(ws + WS_WQK); bf16* VWO = (bf16*)(ws + WS_VWO);
    bf16* HB = (bf16*)(ws + WS_HB); bf16* PB = (bf16*)(ws + WS_P);
    float* tailG = (float*)(ws + WS_HALO); float* headG = (float*)(ws + WS_HALO + HALO_ONE); float* headU = (float*)(ws + WS_HALO + 2 * HALO_ONE);
    unsigned* cmax1U = (unsigned*)(ws + WS_CTL) + CW_CMAX1; unsigned* cmaxU = (unsigned*)(ws + WS_CTL) + CW_CMAX; unsigned* rmaxU = (unsigned*)(ws + WS_CTL) + CW_RMAX;
    float* rsq1 = (float*)(ws + WS_CTL) + CW_RSQ1; float* rsq2 = (float*)(ws + WS_CTL) + CW_RSQ2; float* rsq3 = (float*)(ws + WS_CTL) + CW_RSQ3;
    bf16* U0 = (bf16*)out; bf16* CH = U0 + (size_t)MTOK * CWID; bf16* BG = CH + (size_t)MTOK * CWID;

    if (tid < 32) MISC[tid] = 0u;
    __syncthreads();
    XcdBarrier bar; bar.bar = (unsigned*)(ctl + CW_BAR); bar.x = 0; bar.st = nullptr;
    if (MK_N_LAUNCHES == 1) bar = xcd_barrier_post((unsigned*)(ctl + CW_BAR), MISC + 8);
    const int lo = args.ph_lo, hi = args.ph_hi;
#define IN(k) (lo <= (k) && (k) < hi)
#define BOTH(k) (IN(k) && IN((k) + 1))
#define GRID_BAR() xcd_barrier(bar)
#define REPS(k) _Pragma("unroll") for (int rep_ = 0; rep_ <= ((DUP_MASK >> (k)) & 1); ++rep_)
    float* dummy_out = (float*)(ws + WS_END); float* dummy_rsq = (float*)(ws + WS_END + (size_t)MTOK * DM * 4);
    LAS unsigned char* ring = lds + RING_OFF; LAS unsigned char* scr = lds + SCR_OFF;
    const int gw = vcu * NWAVES + wave, NGW = G * NWAVES;

    if (IN(0)) { REPS(0) {
        LAS float* tscr = (LAS float*)(lds + wave * 16640);
        constexpr int I_IN = (DM / 64) * ((INW - 2 * CWID) / 64), I_SQ = (DM / 64) * (DM / 64), I_FF = (DM / 64) * (FF / 64), I_DN = (FF / 64) * (DM / 64);
        constexpr int NITEMS = I_IN + 2 * I_SQ; (void)I_FF; (void)I_DN;
        _Pragma("nounroll") for (int r11_ = 0; r11_ <= ((DUP_MASK >> 11) & 1); ++r11_)
        for (int it = gw; it < NITEMS; it += NGW) {
            int r = it;
            if (r < I_IN) { transpose_item<1>(w_in, DM, INW, WIN, 0, nullptr, tscr, (r / 96) * (INW / 64) + 64 + (r % 96), lane); continue; } r -= I_IN;
            if (r < I_SQ) { transpose_item<0>(w_k, DM, DM, WKV, 0, nullptr, tscr, r, lane); continue; } r -= I_SQ;
            transpose_item<0>(w_v, DM, DM, WKV, DM, nullptr, tscr, r, lane);
        }
        _Pragma("nounroll") for (int r12_ = 0; r12_ <= ((DUP_MASK >> 12) & 1); ++r12_)
        { constexpr int I_CM = (DM / 64) * (FF / 256);
          for (int it = gw; it < 2 * I_CM; it += NGW) { if (it < I_CM) colmax_item<2>(w_gate, FF, g_ffn, cmaxU, it, lane); else colmax_item<3>(w_up, FF, g_ffn, cmaxU, it - I_CM, lane); }
          for (int it = gw; it < (DM / 64) * 16; it += NGW) colmax_item<1>(w_in, INW, nullptr, cmax1U, (it / 16) * (INW / 256) + (it % 16), lane); }
        _Pragma("nounroll") for (int r13_ = 0; r13_ <= ((DUP_MASK >> 13) & 1); ++r13_)
        rms_rows<true>(x, g_mix, XN, XN8, sA1, MTOK, gw, NGW, lane);
        rms_rows<false>(mem, g_mem, MEMN, nullptr, nullptr, MMEM, gw, NGW, lane);
        __syncthreads(); }
        if (BOTH(0)) GRID_BAR();
    }

    if (IN(1)) {
        { pg8::Gemm g{MEMN, WKV, DM, DM, DM, 1, 1 << 30, 0, 0, 0, 0, 0}; pg8::BatchOrder S; S.init(MMEM / 256, 2 * DM / 256, 1, G, vcu);
          pg8::EpiBf16 E{KV, 2 * DM, nullptr, 1.0f, 1, 0, 0};
          pg8::gemm_phase(ring, scr, g, S, E); }
        { constexpr int NKV = (MMEM / 256) * (2 * DM / 256);
          const bool all = G <= NKV; if (all || vcu >= NKV) { const int cw_ = all ? gw : (vcu - NKV) * NWAVES + wave, ncw = all ? NGW : (G - NKV) * NWAVES;
            { LAS float* qscr = (LAS float*)(lds + wave * 16896); constexpr int I_Q1 = (DM / 128) * (2 * CWID / 32);
              for (int it = cw_; it < I_Q1; it += ncw) quant_item<1>(w_in, DM, INW, WIN8, nullptr, cmax1U, qscr, (it / 128) * (INW / 32) + (it % 128), lane); }
            __syncthreads();
            LAS float* tscr = (LAS float*)(lds + wave * 16640); constexpr int I_SQ = (DM / 64) * (DM / 64);
            for (int it = cw_; it < 2 * I_SQ; it += ncw) { if (it < I_SQ) transpose_item<0>(w_out, DM, DM, WOUT, 0, nullptr, tscr, it, lane); else transpose_item<0>(w_o, DM, DM, WO, 0, nullptr, tscr, it - I_SQ, lane); }
            for (size_t i = (size_t)(cw_ >> 3) * 512 + tid; i < (size_t)DM * DM / 8; i += (size_t)(ncw >> 3) * 512) {
                const f32x4 a = *((const GAS f32x4*)w_q + 2 * i), b = *((const GAS f32x4*)w_q + 2 * i + 1);
                u32x4 w; w.x = cvt_pk_bf16(a[0], a[1]); w.y = cvt_pk_bf16(a[2], a[3]); w.z = cvt_pk_bf16(b[0], b[1]); w.w = cvt_pk_bf16(b[2], b[3]);
                *((GAS u32x4*)WQ + i) = w; } } }
        GRID_BAR();
        REPS(1) {
        { pg8::Gemm g{(const bf16*)XN8, (const bf16*)WIN8, DM / 2, DM / 2, DM / 2, 1, 1 << 30, 0, 0, 0, 0, 0}; pg8::StaticOrder S; S.init(MTOK / 256, 2 * CWID / 256, G, bx);
          LAS float* rtab = (LAS float*)(scr + 4096); if (tid == 0) ((LAS int*)rtab)[256] = -1; __syncthreads();
          pg8::EpiProj<true> E{U0, CH, BG, 0, sA1, cmax1U, rtab};
          pg8::gemm_phase<true>(ring, scr, g, S, E); }
        { pg8::Gemm g{XN, WIN + (size_t)2 * CWID * DM, DM, DM, DM, 1, 1 << 30, 0, 0, 0, 0, 0}; pg8::StaticOrder S; S.init(MTOK / 256, (INW - 2 * CWID) / 256, G, bx);
          pg8::EpiProj<false> E{U0, CH, BG, 2 * CWID / 256, nullptr, nullptr, nullptr};
          pg8::gemm_phase(ring, scr, g, S, E); } }
        if (BOTH(1)) GRID_BAR();
    }

    if (IN(2)) {
        _Pragma("nounroll") for (int rep2_ = 0; rep2_ <= ((DUP_MASK >> 2) & 1); ++rep2_) {
        { LAS unsigned* T = (LAS unsigned*)(lds + wave * 15872);
          conv_a_wave(U0, conv_a_w, conv_a_b, ln_a_g, ln_a_b, MIX, T, gw, NGW, (MTOK / 32) * 16, lane); }
        for (size_t i = (size_t)vcu * 512 + tid; i < (size_t)(MTOK / 4) * (CWID / 8); i += (size_t)G * 512) {
            const int rq = (int)(i >> 8), ch = (int)(i & 255), row0 = rq * 4; const bool first = (row0 % SEQ) == 0;
            const u32x4 z4 = (u32x4){0u, 0u, 0u, 0u};
            u32x4 cv[6], bg[4];
#pragma unroll
            for (int r = 0; r < 6; ++r) cv[r] = (first && r < 2) ? z4 : *(const GAS u32x4*)(CH + (size_t)(row0 - 2 + r) * CWID + ch * 8);
#pragma unroll
            for (int r = 0; r < 4; ++r) bg[r] = *(const GAS u32x4*)(BG + (size_t)(row0 + r) * CWID + ch * 8);
            float w0[8], w1[8], w2[8];
#pragma unroll
            for (int h = 0; h < 2; ++h) { const f32x4 a = *(const GAS f32x4*)(conv_b_w + ch * 8 + 4 * h), b = *(const GAS f32x4*)(conv_b_w + CWID + ch * 8 + 4 * h), c = *(const GAS f32x4*)(conv_b_w + 2 * CWID + ch * 8 + 4 * h);
#pragma unroll
                for (int e = 0; e < 4; ++e) { w0[4 * h + e] = a[e]; w1[4 * h + e] = b[e]; w2[4 * h + e] = c[e]; } }
#pragma unroll
            for (int r = 0; r < 4; ++r) { unsigned ow[4];
#pragma unroll
                for (int p_ = 0; p_ < 4; ++p_) {
                    const float lo_ = bf_lo(bg[r][p_]) * (w0[2 * p_] * bf_lo(cv[r][p_]) + w1[2 * p_] * bf_lo(cv[r + 1][p_]) + w2[2 * p_] * bf_lo(cv[r + 2][p_]));
                    const float hi_ = bf_hi(bg[r][p_]) * (w0[2 * p_ + 1] * bf_hi(cv[r][p_]) + w1[2 * p_ + 1] * bf_hi(cv[r + 1][p_]) + w2[2 * p_ + 1] * bf_hi(cv[r + 2][p_]));
                    ow[p_] = cvt_pk_bf16(lo_, hi_); }
                *(GAS u32x4*)(MIX + (size_t)(row0 + r) * DM + CWID + ch * 8) = (u32x4){ow[0], ow[1], ow[2], ow[3]}; }
        }
        __syncthreads(); }
        REPS(10) {
        { pg8::Gemm g{KV, WQ, 2 * DM, DM, HDIM, 4, 1 << 30, (size_t)MEMLEN * 2 * DM, (size_t)HDIM, 0, (size_t)HDIM, 0}; pg8::BatchOrder S; S.init(1, DM / 256, 16, G, vcu);
          pg8::EpiBf16 E{WQK, DM, g_xattn, 0.03125f * LOG2E, 16, 0, (size_t)MEMLEN * DM};
          pg8::gemm_phase(ring, scr, g, S, E); }
        { pg8::Gemm g{WO, KV + DM, DM, 2 * DM, HDIM, 4, 1 << 30, 0, (size_t)HDIM, (size_t)MEMLEN * 2 * DM, (size_t)HDIM, 0}; pg8::BatchOrder S; S.init(DM / 256, 1, 16, G, vcu);
          pg8::EpiBf16 E{VWO, NHEAD * MEMLEN, nullptr, 1.0f, 4, (size_t)DM * NHEAD * MEMLEN, (size_t)MEMLEN};
          pg8::gemm_phase(ring, scr, g, S, E); } }
        if (BOTH(2)) GRID_BAR();
    }

    if (IN(3)) {
        pg8::Gemm g{MIX, WOUT, DM, DM, DM, 1, 1 << 30, 0, 0, 0, 0, 0}; pg8::StaticOrder S; S.init(MTOK / 256, DM / 256, G, bx);
        constexpr int I_Q8 = (DM / 128) * (FF / 32); const int hq = G >> 1;
        if ((bx & 1) && hq > 0) { LAS float* qscr = (LAS float*)(lds + wave * 16896);
            for (int it = (bx >> 1) * NWAVES + wave; it < I_Q8; it += hq * NWAVES) quant_item<2>(w_gate, DM, FF, WGU8, g_ffn, cmaxU, qscr, it, lane);
            __syncthreads(); }
        REPS(3) { pg8::EpiResid<false> E{x, HB, rep_ ? dummy_rsq : rsq1, nullptr, DM};
        pg8::gemm_phase(ring, scr, g, S, E); }
        if (!(bx & 1) || hq == 0) { LAS float* qscr = (LAS float*)(lds + wave * 16896); const int nq = hq > 0 ? (G - hq) : G, iq = hq > 0 ? (bx >> 1) : bx;
            for (int it = iq * NWAVES + wave; it < I_Q8; it += nq * NWAVES) quant_item<3>(w_up, DM, FF, WGU8, g_ffn, cmaxU, qscr, it, lane);
            if (hq == 0) for (int it = iq * NWAVES + wave; it < I_Q8; it += nq * NWAVES) quant_item<2>(w_gate, DM, FF, WGU8, g_ffn, cmaxU, qscr, it, lane); }
        if (BOTH(3)) GRID_BAR();
    }

    if (IN(4)) {
        pg8::Gemm g{HB, WQK, DM, DM, DM, 1, SEQ / 256, 0, 0, 0, 0, (size_t)NHEAD * MEMLEN * DM}; pg8::StaticOrder S; S.init(MTOK / 256, NHEAD, G, bx);
        pg8::EpiSoftmax E{PB, rsq1, NHEAD * MEMLEN};
        REPS(4) pg8::gemm_phase(ring, scr, g, S, E);
        if (BOTH(4)) GRID_BAR();
    }

    if (IN(5)) {
        pg8::Gemm g{PB, VWO, NHEAD * MEMLEN, NHEAD * MEMLEN, NHEAD * MEMLEN, 1, SEQ / 256, 0, 0, 0, 0, (size_t)DM * NHEAD * MEMLEN}; pg8::StaticOrder S; S.init(MTOK / 256, DM / 256, G, bx);
        REPS(5) { pg8::EpiResid<true> E{HB, rep_ ? (bf16*)dummy_out : HB, rep_ ? dummy_rsq : rsq2, rep_ ? (unsigned*)nullptr : rmaxU, DM};
        pg8::gemm_phase(ring, scr, g, S, E); }
        GRID_BAR();
        for (int m = gw; m < MTOK; m += NGW) quant_row_i8(HB + (size_t)m * DM, A8 + (size_t)m * DM, __uint_as_float(__hip_atomic_load(rmaxU + m, __ATOMIC_RELAXED, __HIP_MEMORY_SCOPE_AGENT)), lane);
        if (BOTH(5)) GRID_BAR();
    }

    if (IN(6)) {
        pg8::Gemm g{(const bf16*)A8, (const bf16*)WGU8, DM / 2, DM / 2, DM / 2, 1, 1 << 30, 0, 0, 0, 0, 0}; pg8::StaticOrder S; S.init(MTOK / 256, 2 * FF / 256, G, bx);
        LAS float* rtab = (LAS float*)(scr + 4096); if (tid == 0) ((LAS int*)rtab)[256] = -1; __syncthreads();
        pg8::EpiGateUp<true, 1 + ((DUP_MASK >> 17) & 1)> E{FB, rsq2, conv_f_w, tailG, headG, headU, rmaxU, cmaxU, rtab};
        REPS(6) pg8::gemm_phase<true>(ring, scr, g, S, E);
    }
    if (IN(6)) {
        constexpr int NU = (2 * FF / 256) * (MTOK / 256); const int last = NU / G, used = NU - last * G, nfree = G - used, myidx = bx - used;
        if (myidx >= 0) { LAS float* tscr = (LAS float*)(lds + wave * 16640); constexpr int I_DN = (FF / 64) * (DM / 64);
            for (int it = myidx * NWAVES + wave; it < I_DN; it += nfree * NWAVES) transpose_item<0>(w_down, FF, DM, WDN, 0, nullptr, tscr, it, lane); }
        if (BOTH(6)) GRID_BAR();
    }

    if (IN(7)) {
        for (size_t i = (size_t)vcu * 512 + tid; i < (size_t)64 * FF; i += (size_t)G * 512) {
            const int pm = (int)(i / FF), j = (int)(i % FF);
            if ((pm & 15) == 0) continue;
            const float t0 = tailG[(size_t)((pm - 1) * 2 + 0) * FF + j], t1 = tailG[(size_t)((pm - 1) * 2 + 1) * FF + j];
            const float g0 = headG[(size_t)(pm * 2 + 0) * FF + j], g1 = headG[(size_t)(pm * 2 + 1) * FF + j];
            const float u0 = headU[(size_t)(pm * 2 + 0) * FF + j], u1 = headU[(size_t)(pm * 2 + 1) * FF + j];
            const float c0 = conv_f_w[j], c1 = conv_f_w[FF + j], c2 = conv_f_w[2 * FF + j];
            const float a0 = c2 * g0 + c1 * t1 + c0 * t0, a1 = c2 * g1 + c1 * g0 + c0 * t1;
            const unsigned p0 = cvt_pk_bf16(a0 * fast_sigmoid(a0) * u0, 0.f), p1 = cvt_pk_bf16(a1 * fast_sigmoid(a1) * u1, 0.f);
            FB[(size_t)(pm * 256 + 0) * FF + j] = (bf16)(p0 & 0xffffu); FB[(size_t)(pm * 256 + 1) * FF + j] = (bf16)(p1 & 0xffffu);
        }
        if (BOTH(7)) GRID_BAR();
    }

    if (IN(8)) {
        pg8::Gemm g{FB, WDN, FF, FF, FF, 1, 1 << 30, 0, 0, 0, 0, 0}; pg8::BatchOrder S; S.init(MTOK / 256, DM / 256, 1, G, vcu);
        { pg8::EpiResid<true> E{HB, HB, rsq3, nullptr, DM}; pg8::gemm_phase(ring, scr, g, S, E); }
        if ((DUP_MASK >> 8) & 1) { pg8::EpiResid<true> E{HB, (bf16*)dummy_out, dummy_rsq, nullptr, DM}; pg8::gemm_phase<false, DUP_VAR>(ring, scr, g, S, E); }
        if (BOTH(8)) GRID_BAR();
    }

    if (IN(9)) {
        if ((DUP_MASK >> 14) & 1) { _Pragma("nounroll") for (int r14_ = 0; r14_ < 8; ++r14_) GRID_BAR(); }
        const bool bad = (MK_N_LAUNCHES == 1) && (__hip_atomic_load(ctl + CW_BAR + XB_TMO, __ATOMIC_RELAXED, __HIP_MEMORY_SCOPE_AGENT) != 0u);
        REPS(9) { const bool dup_ = rep_ < ((DUP_MASK >> 9) & 1);
        f32x4 gv[16];
#pragma unroll
        for (int j = 0; j < 16; ++j) gv[j] = *((const GAS f32x4*)g_final + lane + 64 * j);
        for (int m = gw; m < MTOK; m += 2 * NGW) {
            const int mb = (m + NGW < MTOK) ? m + NGW : m;
            const float ra = bad ? __builtin_nanf("") : pg8::row_rstd(rsq3, m), rb = bad ? __builtin_nanf("") : pg8::row_rstd(rsq3, mb);
            u32x2 ha[16], hb[16];
#pragma unroll
            for (int j = 0; j < 16; ++j) { ha[j] = *((const GAS u32x2*)(HB + (size_t)m * DM) + lane + 64 * j); hb[j] = *((const GAS u32x2*)(HB + (size_t)mb * DM) + lane + 64 * j); }
            GAS f32x4* wa = (GAS f32x4*)((dup_ ? dummy_out : out) + (size_t)m * DM) + lane; GAS f32x4* wb = (GAS f32x4*)((dup_ ? dummy_out : out) + (size_t)mb * DM) + lane;
#pragma unroll
            for (int j = 0; j < 16; ++j) wa[64 * j] = (f32x4){bf_lo(ha[j].x), bf_hi(ha[j].x), bf_lo(ha[j].y), bf_hi(ha[j].y)} * ra * gv[j];
            if (mb != m) {
#pragma unroll
                for (int j = 0; j < 16; ++j) wb[64 * j] = (f32x4){bf_lo(hb[j].x), bf_hi(hb[j].x), bf_lo(hb[j].y), bf_hi(hb[j].y)} * rb * gv[j]; }
        } }
    }
#undef IN
#undef BOTH
#undef GRID_BAR
#undef lane
}

extern "C" void kernel_launch(void* const* d_in, const int* in_sizes, int n_in, void* d_out, int out_size, void* d_ws, size_t ws_size, hipStream_t stream) {
    static int grid = 0;
    if (grid == 0) {
        if (n_in != 22 || in_sizes[0] != MTOK * DM || out_size != MTOK * DM || ws_size < WS_END + (DUP_MASK ? (size_t)257 * MiB : 0)) { fprintf(stderr, "kernel_launch: unexpected shapes (n_in %d, in0 %d, out %d, ws %zu < %zu)\n", n_in, n_in > 0 ? in_sizes[0] : -1, out_size, ws_size, (size_t)WS_END); grid = -1; return; }
        int dev = 0, cus = 0, per_cu = 0;
        if (hipGetDevice(&dev) != hipSuccess || hipDeviceGetAttribute(&cus, hipDeviceAttributeMultiprocessorCount, dev) != hipSuccess) { grid = -1; return; }
        if (hipFuncSetAttribute((const void*)fwd_kernel, hipFuncAttributeMaxDynamicSharedMemorySize, LDS_BYTES) != hipSuccess) { fprintf(stderr, "kernel_launch: hipFuncSetAttribute failed\n"); grid = -1; return; }
        if (hipOccupancyMaxActiveBlocksPerMultiprocessor(&per_cu, (const void*)fwd_kernel, NWAVES * 64, LDS_BYTES) != hipSuccess || per_cu < 1) { fprintf(stderr, "kernel_launch: occupancy query says %d\n", per_cu); }
        (void)hipGetLastError();
        grid = cus;
    }
    if (grid < 0) return;
    if (hipMemsetAsync((char*)d_ws + WS_CTL, 0, CTL_ZERO_BYTES, stream) != hipSuccess) return;
    Args a{};
    for (int i = 0; i < 22; ++i) a.in[i] = (const float*)d_in[i];
    a.out = (float*)d_out; a.ws = (unsigned char*)d_ws;
    if (MK_N_LAUNCHES == 1) {
        a.ph_lo = 0; a.ph_hi = N_PHASES;
        hipLaunchKernelGGL(fwd_kernel, dim3(grid), dim3(NWAVES * 64), LDS_BYTES, stream, a);
    } else {
        for (int p = 0; p < N_PHASES; ++p) { a.ph_lo = p; a.ph_hi = p + 1; hipLaunchKernelGGL(fwd_kernel, dim3(grid), dim3(NWAVES * 64), LDS_BYTES, stream, a); }
    }
}
```

```cpp
#include <hip/hip_runtime.h>
#include <cstdio>

#ifndef MK_N_LAUNCHES
#define MK_N_LAUNCHES 1
#endif
static_assert(MK_N_LAUNCHES == 1, "phases P1 and P5 contain grid barriers of their own: only the one-launch build is supported");
#ifndef DUP_VAR
#define DUP_VAR 0
#endif
#ifndef DUP_MASK
#define DUP_MASK 0x0
#endif

#define GAS __attribute__((address_space(1)))
#define LAS __attribute__((address_space(3)))
typedef unsigned short bf16;
typedef short bf16x8 __attribute__((ext_vector_type(8)));
typedef float f32x4 __attribute__((ext_vector_type(4)));
typedef float f32x2 __attribute__((ext_vector_type(2)));
typedef unsigned u32x4 __attribute__((ext_vector_type(4)));
typedef unsigned u32x2 __attribute__((ext_vector_type(2)));
typedef int i32x4 __attribute__((ext_vector_type(4)));
typedef GAS unsigned gu32;

constexpr int DM = 4096, NBATCH = 4, SEQ = 4096, MTOK = NBATCH * SEQ, MEMLEN = 256, MMEM = NBATCH * MEMLEN;
constexpr int CWID = 2048;
constexpr int INW = 10240;
constexpr int FF = 11008;
constexpr int NHEAD = 4, HDIM = 1024;
constexpr int CONVK = 31;
constexpr float EPS = 1e-6f;
constexpr float LOG2E = 1.4426950408889634f;

__device__ __forceinline__ unsigned cvt_pk_bf16(float lo, float hi) { unsigned r; asm volatile("v_cvt_pk_bf16_f32 %0, %1, %2" : "=v"(r) : "v"(lo), "v"(hi)); return r; }
__device__ __forceinline__ float bf_lo(unsigned w) { return __uint_as_float(w << 16); }
__device__ __forceinline__ float bf_hi(unsigned w) { return __uint_as_float(w & 0xffff0000u); }
__device__ __forceinline__ float fast_sigmoid(float x) { return __builtin_amdgcn_rcpf(1.0f + __builtin_amdgcn_exp2f(-x * LOG2E)); }
template <int N> __device__ __forceinline__ float dpp_shr(float v) { return __int_as_float(__builtin_amdgcn_update_dpp(0, __float_as_int(v), 0x110 + N, 0xf, 0xf, true)); }
template <int N> __device__ __forceinline__ float dpp_shl(float v) { return __int_as_float(__builtin_amdgcn_update_dpp(0, __float_as_int(v), 0x100 + N, 0xf, 0xf, true)); }
__device__ __forceinline__ float wave_sum(float v) {
#pragma unroll
    for (int o = 1; o < 64; o <<= 1) v += __shfl_xor(v, o);
    return v;
}

namespace pg8 {
constexpr int BM = 256, BK = 64, HALF = 128, HTB = HALF * BK * 2, STAGE_BYTES = 8 * HTB, NXCD = 8, WGM = 8;
__host__ __device__ __forceinline__ int lds_byte(int r, int c) { const int st = (r >> 4) * 2 + (c >> 5), rr = r & 15, cc = c & 31, ob = rr * 64 + cc * 2; return st * 1024 + (ob ^ (((ob >> 9) & 1) << 5)); }
__host__ __device__ __forceinline__ void stage_rc(int b, int& R, int& C) { const int st = b / 1024, sb = b % 1024, swz = sb ^ (((sb >> 9) & 1) << 5); R = (st >> 1) * 16 + swz / 64; C = (st & 1) * 32 + (swz % 64) / 2; }
__host__ __device__ __forceinline__ int perm32(int rho) { const int n = rho >> 4, i = rho & 15; return 8 * (i >> 2) + 4 * n + (i & 3); }

struct Unit { int pm, pn, z; };
struct Gemm { const bf16* A; const bf16* Bt; int lda, ldb, K, zdiv, bdiv; size_t sAhi, sAlo, sBhi, sBlo, sBpm; };
__device__ __forceinline__ const char* unitA(const Gemm& g, const Unit& u) { return (const char*)(g.A + (size_t)(u.z / g.zdiv) * g.sAhi + (size_t)(u.z % g.zdiv) * g.sAlo + (size_t)u.pm * BM * g.lda); }
__device__ __forceinline__ const char* unitB(const Gemm& g, const Unit& u) { return (const char*)(g.Bt + (size_t)(u.z / g.zdiv) * g.sBhi + (size_t)(u.z % g.zdiv) * g.sBlo + (size_t)(u.pm / g.bdiv) * g.sBpm + (size_t)u.pn * BM * g.ldb); }

struct StaticOrder {
    int nM, nN, nwg, G, c;
    __device__ void init(int nM_, int nN_, int G_, int c_) { nM = nM_; nN = nN_; nwg = nM * nN; G = G_; c = c_; }
    __device__ bool next(int i, Unit& u) const {
        const long L = (long)i * G + c; if (L >= nwg) return false;
        int wgid = (int)L; { const int q = nwg / NXCD, r = nwg % NXCD, xcd = wgid % NXCD, off = wgid / NXCD; wgid = (xcd < r ? xcd * (q + 1) : r * (q + 1) + (xcd - r) * q) + off; }
        const int nig = WGM * nN, gid = wgid / nig, fm = gid * WGM, gsz = (nM - fm) < WGM ? (nM - fm) : WGM;
        u.pm = fm + ((wgid % nig) % gsz); u.pn = (wgid % nig) / gsz; u.z = 0; return true;
    }
};
struct BatchOrder {
    int nM, nN, nZ, G, c;
    __device__ void init(int nM_, int nN_, int nZ_, int G_, int c_) { nM = nM_; nN = nN_; nZ = nZ_; G = G_; c = c_; }
    __device__ bool next(int i, Unit& u) const {
        const long L = (long)i * G + c; if (L >= (long)nM * nN * nZ) return false;
        const int per = nM * nN, l = (int)L; u.z = l / per; const int rem = l % per; u.pm = rem / nN; u.pn = rem % nN; return true;
    }
};

template <bool I8 = false, int VAR = 0, class Epi, class Sched>
__device__ __forceinline__ void gemm_phase(LAS unsigned char* lds, LAS unsigned char* scr, const Gemm g, const Sched& S, const Epi& E) {
    const int tid = threadIdx.x, wid = __builtin_amdgcn_readfirstlane(tid >> 6), lane = tid & 63, wr = wid >> 2, wc = wid & 3, fr = lane & 15, fq = lane >> 4;
    const int K = g.K, nt = K / BK;
    unsigned voffA[2], voffB[2];
#pragma unroll
    for (int i = 0; i < 2; ++i) { int R, C; stage_rc(tid * 16 + i * 8192, R, C); const int Rb = Epi::PERM ? ((R & ~31) + perm32(R & 31)) : R;
        voffA[i] = (unsigned)(R * g.lda + C) * 2u; voffB[i] = (unsigned)(Rb * g.ldb + C) * 2u; }
    const size_t kstep = (size_t)(BK * 2);
    const size_t hstepA = (size_t)HALF * g.lda * 2, hstepB = (size_t)HALF * g.ldb * 2;
    const unsigned ldsw = (unsigned)wid * 1024u;
    const int aoff = lds_byte(wr * 64 + fr, fq * 8), boff = lds_byte(wc * 32 + fr, fq * 8);
#define PG8_SA(b, h) (((b) * 2 + (h)) * HTB)
#define PG8_SB(b, h) ((4 + (b) * 2 + (h)) * HTB)
#define PG8_STAGE(bufoff, gbase, voff) do { if constexpr (VAR != 1 && VAR != 3) { _Pragma("unroll") for (int _i = 0; _i < 2; ++_i) \
        __builtin_amdgcn_global_load_lds((const unsigned*)((const char*)(gbase) + (voff)[_i]), (LAS unsigned*)(lds + (bufoff) + ldsw + _i * 8192), 16, 0, 0); } } while (0)
#define PG8_LDA(dst, b, h) do { if constexpr (VAR < 2) _Pragma("unroll") for (int m = 0; m < 4; ++m) _Pragma("unroll") for (int k = 0; k < 2; ++k) dst[m][k] = *(const LAS bf16x8*)(lds + PG8_SA(b, h) + aoff + m * 2048 + k * 1024); } while (0)
#define PG8_LDB(dst, b, h) do { if constexpr (VAR < 2) _Pragma("unroll") for (int n = 0; n < 2; ++n) _Pragma("unroll") for (int k = 0; k < 2; ++k) dst[n][k] = *(const LAS bf16x8*)(lds + PG8_SB(b, h) + boff + n * 2048 + k * 1024); } while (0)
#define PG8_MMA(ai, bj, At, Bt) do { __builtin_amdgcn_s_setprio(1); _Pragma("unroll") for (int m = 0; m < 4; ++m) _Pragma("unroll") for (int n = 0; n < 2; ++n) _Pragma("unroll") for (int k = 0; k < 2; ++k) \
        { if constexpr (I8) acc[ai][bj][m][n] = __builtin_bit_cast(f32x4, __builtin_amdgcn_mfma_i32_16x16x64_i8(__builtin_bit_cast(i32x4, Bt[n][k]), __builtin_bit_cast(i32x4, At[m][k]), __builtin_bit_cast(i32x4, acc[ai][bj][m][n]), 0, 0, 0)); \
          else acc[ai][bj][m][n] = __builtin_amdgcn_mfma_f32_16x16x32_bf16(Bt[n][k], At[m][k], acc[ai][bj][m][n], 0, 0, 0); } __builtin_amdgcn_s_setprio(0); } while (0)
#define PG8_WAIT_V(n) asm volatile("s_waitcnt vmcnt(" #n ")" ::: "memory")
#define PG8_WAIT_L(n) asm volatile("s_waitcnt lgkmcnt(" #n ")" ::: "memory")
#define PG8_BAR do { if constexpr (VAR != 3) __builtin_amdgcn_s_barrier(); } while (0)
#define PG8_SCHED __builtin_amdgcn_sched_barrier(0)
    Unit cur, nxt; int ui = 0;
    if (!S.next(0, cur)) return;
    f32x4 acc[2][2][4][2];
#pragma unroll
    for (int a = 0; a < 2; ++a)
#pragma unroll
        for (int b = 0; b < 2; ++b)
#pragma unroll
            for (int m = 0; m < 4; ++m)
#pragma unroll
                for (int n = 0; n < 2; ++n) acc[a][b][m][n] = (f32x4){0.f, 0.f, 0.f, 0.f};
    bf16x8 At[4][2], B0[2][2], B1[2][2];
    if constexpr (VAR >= 2) {
#pragma unroll
        for (int m = 0; m < 4; ++m)
#pragma unroll
            for (int k = 0; k < 2; ++k) { const unsigned h_ = (unsigned)(tid * 2654435761u + (m * 2 + k) * 40503u); const u32x4 q_ = (u32x4){h_ & 0x3fff3fffu, (h_ * 3u) & 0x3fff3fffu, (h_ * 5u) & 0x3fff3fffu, (h_ * 7u) & 0x3fff3fffu}; At[m][k] = __builtin_bit_cast(bf16x8, q_);
                if (m < 2) { B0[m][k] = __builtin_bit_cast(bf16x8, q_ ^ 0x01010101u); B1[m][k] = __builtin_bit_cast(bf16x8, q_ ^ 0x02040204u); } }
    }
    const char* cA = unitA(g, cur); const char* cB = unitB(g, cur);
    PG8_STAGE(PG8_SB(0, 0), cB, voffB); PG8_STAGE(PG8_SB(0, 1), cB + hstepB, voffB); PG8_STAGE(PG8_SA(0, 0), cA, voffA); PG8_STAGE(PG8_SA(0, 1), cA + hstepA, voffA);
    if (wr == 1) PG8_BAR;
    PG8_WAIT_V(2); PG8_BAR;
    PG8_STAGE(PG8_SB(1, 0), cB + kstep, voffB); PG8_STAGE(PG8_SA(1, 0), cA + kstep, voffA); PG8_STAGE(PG8_SB(1, 1), cB + hstepB + kstep, voffB);
    PG8_WAIT_V(6); PG8_BAR;
    for (;;) {
        const bool has_next = S.next(ui + 1, nxt);
        const char* nA = has_next ? unitA(g, nxt) : cA; const char* nB = has_next ? unitB(g, nxt) : cB;
        for (int t = 0; t < nt; t += 2) {
            const bool last = (t == nt - 2);
            const char* a1 = cA + (size_t)(t + 1) * kstep;
            const char* a2 = last ? nA : cA + (size_t)(t + 2) * kstep; const char* b2 = last ? nB : cB + (size_t)(t + 2) * kstep;
            const char* a3 = a2 + kstep; const char* b3 = b2 + kstep;
            PG8_LDB(B0, 0, 0); PG8_LDB(B1, 0, 1); PG8_SCHED; PG8_LDA(At, 0, 0); PG8_STAGE(PG8_SA(1, 1), a1 + hstepA, voffA);
            PG8_WAIT_V(8); PG8_WAIT_L(0); PG8_BAR; PG8_MMA(0, 0, At, B0); PG8_MMA(0, 1, At, B1); PG8_BAR; PG8_SCHED;
            PG8_LDA(At, 0, 1); PG8_STAGE(PG8_SB(0, 0), b2, voffB); PG8_STAGE(PG8_SB(0, 1), b2 + hstepB, voffB); PG8_STAGE(PG8_SA(0, 0), a2, voffA);
            PG8_WAIT_V(8); PG8_WAIT_L(0); PG8_BAR; PG8_MMA(1, 0, At, B0); PG8_MMA(1, 1, At, B1); PG8_BAR; PG8_SCHED;
            PG8_LDB(B0, 1, 0); PG8_LDB(B1, 1, 1); PG8_SCHED; PG8_LDA(At, 1, 0); PG8_STAGE(PG8_SA(0, 1), a2 + hstepA, voffA);
            PG8_WAIT_V(8); PG8_WAIT_L(0); PG8_BAR; PG8_MMA(0, 0, At, B0); PG8_MMA(0, 1, At, B1); PG8_BAR; PG8_SCHED;
            PG8_LDA(At, 1, 1); PG8_STAGE(PG8_SB(1, 0), b3, voffB); PG8_STAGE(PG8_SB(1, 1), b3 + hstepB, voffB); PG8_STAGE(PG8_SA(1, 0), a3, voffA);
            PG8_WAIT_V(8); PG8_WAIT_L(0); PG8_BAR; PG8_MMA(1, 0, At, B0); PG8_MMA(1, 1, At, B1); PG8_BAR; PG8_SCHED;
        }
        if (wr == 0) PG8_BAR;
        E(acc, cur, wr, wc, fr, fq, scr, has_next ? &nxt : nullptr);
        if (!has_next) break;
#pragma unroll
        for (int a = 0; a < 2; ++a)
#pragma unroll
            for (int b = 0; b < 2; ++b)
#pragma unroll
                for (int m = 0; m < 4; ++m)
#pragma unroll
                    for (int n = 0; n < 2; ++n) acc[a][b][m][n] = (f32x4){0.f, 0.f, 0.f, 0.f};
        cur = nxt; cA = nA; cB = nB; ++ui;
        if (wr == 1) PG8_BAR;
    }
    PG8_WAIT_V(0);
    PG8_BAR;
#undef PG8_SA
#undef PG8_SB
#undef PG8_STAGE
#undef PG8_LDA
#undef PG8_LDB
#undef PG8_MMA
#undef PG8_WAIT_V
#undef PG8_WAIT_L
#undef PG8_BAR
#undef PG8_SCHED
}

#define EPI_ARGS f32x4 (&acc)[2][2][4][2], const Unit& u, int wr, int wc, int fr, int fq, LAS unsigned char* scr, const Unit* nx
#define EPI_BAR() do { asm volatile("s_waitcnt lgkmcnt(0)" ::: "memory"); __builtin_amdgcn_s_barrier(); asm volatile("" ::: "memory"); } while (0)

struct EpiBf16 {
    static constexpr bool PERM = true;
    bf16* O; int ldc; const float* colscale; float scale; int zdiv; size_t sChi, sClo;
    __device__ __forceinline__ void operator()(EPI_ARGS) const {
        bf16* base = O + (size_t)(u.z / zdiv) * sChi + (size_t)(u.z % zdiv) * sClo;
        const int row0 = u.pm * BM + wr * 64 + fr, col0 = u.pn * BM + wc * 32 + 8 * fq;
        f32x4 cs[2][2];
#pragma unroll
        for (int bj = 0; bj < 2; ++bj)
#pragma unroll
            for (int n = 0; n < 2; ++n) { cs[bj][n] = colscale ? *(const f32x4*)(colscale + col0 + bj * HALF + 4 * n) : (f32x4){1.f, 1.f, 1.f, 1.f}; cs[bj][n] = cs[bj][n] * scale; }
#pragma unroll
        for (int ai = 0; ai < 2; ++ai)
#pragma unroll
            for (int m = 0; m < 4; ++m) { bf16* rowp = base + (size_t)(row0 + ai * HALF + m * 16) * ldc + col0;
#pragma unroll
                for (int bj = 0; bj < 2; ++bj) { const f32x4 v0 = acc[ai][bj][m][0] * cs[bj][0], v1 = acc[ai][bj][m][1] * cs[bj][1];
                    u32x4 w; w.x = cvt_pk_bf16(v0[0], v0[1]); w.y = cvt_pk_bf16(v0[2], v0[3]); w.z = cvt_pk_bf16(v1[0], v1[1]); w.w = cvt_pk_bf16(v1[2], v1[3]);
                    *(u32x4*)(rowp + bj * HALF) = w; } }
    }
};

template <bool I8> struct EpiProj {
    static constexpr bool PERM = true;
    bf16 *U0, *CH, *BG; int pn_off; const float* sA; const unsigned* cmaxB; LAS float* rtab;
    __device__ __forceinline__ void operator()(EPI_ARGS) const {
        const int row0 = u.pm * BM + wr * 64 + fr, c8 = wc * 32 + 8 * fq, pn = u.pn + pn_off;
        if (I8) { if (__builtin_amdgcn_readfirstlane(((LAS int*)rtab)[256]) != u.pm) { EPI_BAR(); if (threadIdx.x < 256) rtab[threadIdx.x] = sA[u.pm * BM + threadIdx.x]; if (threadIdx.x == 0) ((LAS int*)rtab)[256] = u.pm; EPI_BAR(); } }
        if (I8 || pn < 32) {
            const bool glu = I8 || pn < 16;
            bf16* base = (glu ? U0 : CH) + (size_t)((pn & 15) * HALF + c8);
            f32x4 sb[2][2];
            if (I8) {
#pragma unroll
                for (int bj = 0; bj < 2; ++bj)
#pragma unroll
                    for (int n = 0; n < 2; ++n) { const u32x4 cm = *(const u32x4*)(cmaxB + pn * BM + bj * HALF + c8 + 4 * n); sb[bj][n] = (f32x4){__uint_as_float(cm.x), __uint_as_float(cm.y), __uint_as_float(cm.z), __uint_as_float(cm.w)} * (1.0f / 127.0f); } }
#pragma unroll
            for (int ai = 0; ai < 2; ++ai)
#pragma unroll
                for (int m = 0; m < 4; ++m) {
                    const float rs = I8 ? rtab[wr * 64 + fr + ai * HALF + m * 16] : 1.0f;
                    f32x4 o[2];
#pragma unroll
                    for (int n = 0; n < 2; ++n) { f32x4 a = acc[ai][0][m][n], b = acc[ai][1][m][n];
                        if (I8) { const i32x4 ia = __builtin_bit_cast(i32x4, a), ib = __builtin_bit_cast(i32x4, b);
                            a = (f32x4){(float)ia[0], (float)ia[1], (float)ia[2], (float)ia[3]} * (sb[0][n] * rs); b = (f32x4){(float)ib[0], (float)ib[1], (float)ib[2], (float)ib[3]} * (sb[1][n] * rs); }
#pragma unroll
                        for (int e = 0; e < 4; ++e) o[n][e] = glu ? a[e] * fast_sigmoid(b[e]) : a[e] * b[e]; }
                    u32x4 w; w.x = cvt_pk_bf16(o[0][0], o[0][1]); w.y = cvt_pk_bf16(o[0][2], o[0][3]); w.z = cvt_pk_bf16(o[1][0], o[1][1]); w.w = cvt_pk_bf16(o[1][2], o[1][3]);
                    *(u32x4*)(base + (size_t)(row0 + ai * HALF + m * 16) * CWID) = w; }
        } else {
            bf16* base = BG + (size_t)((pn - 32) * BM + c8);
#pragma unroll
            for (int ai = 0; ai < 2; ++ai)
#pragma unroll
                for (int m = 0; m < 4; ++m)
#pragma unroll
                    for (int bj = 0; bj < 2; ++bj) { const f32x4 v0 = acc[ai][bj][m][0], v1 = acc[ai][bj][m][1];
                        u32x4 w; w.x = cvt_pk_bf16(v0[0], v0[1]); w.y = cvt_pk_bf16(v0[2], v0[3]); w.z = cvt_pk_bf16(v1[0], v1[1]); w.w = cvt_pk_bf16(v1[2], v1[3]);
                        *(u32x4*)(base + (size_t)(row0 + ai * HALF + m * 16) * CWID + bj * HALF) = w; }
        }
    }
};

template <bool RES_BF16> struct EpiResid {
    static constexpr bool PERM = true;
    const void* resid; bf16* ob; float* rowsq; unsigned* rowmax; int ldc;
    __device__ __forceinline__ void operator()(EPI_ARGS) const {
        const int row0 = u.pm * BM + wr * 64 + fr, col0 = u.pn * BM + wc * 32 + 8 * fq;
        float ssv[8], mxv[8];
#pragma unroll
        for (int ai = 0; ai < 2; ++ai) {
            f32x4 r0[4][2], r1[4][2];
#pragma unroll
            for (int m = 0; m < 4; ++m)
#pragma unroll
                for (int bj = 0; bj < 2; ++bj) { const size_t off = (size_t)(row0 + ai * HALF + m * 16) * ldc + col0 + bj * HALF;
                    if (RES_BF16) { const u32x4 rw = *(const u32x4*)((const bf16*)resid + off); r0[m][bj] = __builtin_bit_cast(f32x4, rw); }
                    else { r0[m][bj] = *(const f32x4*)((const float*)resid + off); r1[m][bj] = *(const f32x4*)((const float*)resid + off + 4); } }
#pragma unroll
            for (int m = 0; m < 4; ++m) { const int row = row0 + ai * HALF + m * 16; const size_t off = (size_t)row * ldc + col0; float ss = 0.f, mx = 0.f;
#pragma unroll
                for (int bj = 0; bj < 2; ++bj) {
                    f32x4 a0, a1;
                    if (RES_BF16) { const u32x4 rw = __builtin_bit_cast(u32x4, r0[m][bj]); a0 = (f32x4){bf_lo(rw.x), bf_hi(rw.x), bf_lo(rw.y), bf_hi(rw.y)}; a1 = (f32x4){bf_lo(rw.z), bf_hi(rw.z), bf_lo(rw.w), bf_hi(rw.w)}; }
                    else { a0 = r0[m][bj]; a1 = r1[m][bj]; }
                    const f32x4 v0 = acc[ai][bj][m][0] + a0, v1 = acc[ai][bj][m][1] + a1;
                    u32x4 w; w.x = cvt_pk_bf16(v0[0], v0[1]); w.y = cvt_pk_bf16(v0[2], v0[3]); w.z = cvt_pk_bf16(v1[0], v1[1]); w.w = cvt_pk_bf16(v1[2], v1[3]); *(u32x4*)(ob + off + bj * HALF) = w;
                    ss += (v0[0] * v0[0] + v0[1] * v0[1]) + (v0[2] * v0[2] + v0[3] * v0[3]) + (v1[0] * v1[0] + v1[1] * v1[1]) + (v1[2] * v1[2] + v1[3] * v1[3]);
                    if (rowmax) mx = fmaxf(mx, fmaxf(fmaxf(fmaxf(fabsf(v0[0]), fabsf(v0[1])), fmaxf(fabsf(v0[2]), fabsf(v0[3]))), fmaxf(fmaxf(fabsf(v1[0]), fabsf(v1[1])), fmaxf(fabsf(v1[2]), fabsf(v1[3]))))); }
                ss += __shfl_xor(ss, 16); ss += __shfl_xor(ss, 32); ssv[ai * 4 + m] = ss;
                if (rowmax) { mx = fmaxf(mx, __shfl_xor(mx, 16)); mx = fmaxf(mx, __shfl_xor(mx, 32)); } mxv[ai * 4 + m] = mx; }
            asm volatile("" ::: "memory"); }
        float s0 = 0.f, s1 = 0.f, m0 = 0.f, m1 = 0.f;
#pragma unroll
        for (int k = 0; k < 8; ++k) if ((k >> 1) == fq) { if (k & 1) { s1 = ssv[k]; m1 = mxv[k]; } else { s0 = ssv[k]; m0 = mxv[k]; } }
        const int rq = row0 + (fq >> 1) * HALF + (fq & 1) * 32;
        __hip_atomic_fetch_add(rowsq + rq, s0, __ATOMIC_RELAXED, __HIP_MEMORY_SCOPE_AGENT); __hip_atomic_fetch_add(rowsq + rq + 16, s1, __ATOMIC_RELAXED, __HIP_MEMORY_SCOPE_AGENT);
        if (rowmax) { __hip_atomic_fetch_max(rowmax + rq, __float_as_uint(m0), __ATOMIC_RELAXED, __HIP_MEMORY_SCOPE_AGENT); __hip_atomic_fetch_max(rowmax + rq + 16, __float_as_uint(m1), __ATOMIC_RELAXED, __HIP_MEMORY_SCOPE_AGENT); }
    }
};

__device__ __forceinline__ float row_rstd(const float* rowsq, int row) { return 1.0f / sqrtf(__hip_atomic_load(rowsq + row, __ATOMIC_RELAXED, __HIP_MEMORY_SCOPE_AGENT) * (1.0f / DM) + EPS); }

struct EpiSoftmax {
    static constexpr bool PERM = true;
    bf16* P; const float* rowsq; int ldc;
    __device__ __forceinline__ void operator()(EPI_ARGS) const {
        LAS float* RM = (LAS float*)scr;
        LAS float* RS = RM + 1024;
        const int rl0 = wr * 64 + fr;
#pragma unroll
        for (int ai = 0; ai < 2; ++ai)
#pragma unroll
            for (int m = 0; m < 4; ++m) { const int rl = rl0 + ai * HALF + m * 16; const float rs = row_rstd(rowsq, u.pm * BM + rl); float mx = -3.0e38f;
#pragma unroll
                for (int bj = 0; bj < 2; ++bj)
#pragma unroll
                    for (int n = 0; n < 2; ++n) { acc[ai][bj][m][n] = acc[ai][bj][m][n] * rs; const f32x4 v = acc[ai][bj][m][n]; mx = fmaxf(mx, fmaxf(fmaxf(v[0], v[1]), fmaxf(v[2], v[3]))); }
                mx = fmaxf(mx, __shfl_xor(mx, 16)); mx = fmaxf(mx, __shfl_xor(mx, 32));
                if (fq == 0) RM[rl * 4 + wc] = mx; }
        EPI_BAR();
#pragma unroll
        for (int ai = 0; ai < 2; ++ai)
#pragma unroll
            for (int m = 0; m < 4; ++m) { const int rl = rl0 + ai * HALF + m * 16; const f32x4 m4 = *(const LAS f32x4*)(RM + rl * 4); const float mx = fmaxf(fmaxf(m4[0], m4[1]), fmaxf(m4[2], m4[3])); float sm = 0.f;
#pragma unroll
                for (int bj = 0; bj < 2; ++bj)
#pragma unroll
                    for (int n = 0; n < 2; ++n) { f32x4 v = acc[ai][bj][m][n];
#pragma unroll
                        for (int e = 0; e < 4; ++e) { v[e] = __builtin_amdgcn_exp2f(v[e] - mx); sm += v[e]; }
                        acc[ai][bj][m][n] = v; }
                sm += __shfl_xor(sm, 16); sm += __shfl_xor(sm, 32);
                if (fq == 0) RS[rl * 4 + wc] = sm; }
        EPI_BAR();
        const int row0 = u.pm * BM + rl0, col0 = u.pn * BM + wc * 32 + 8 * fq;
#pragma unroll
        for (int ai = 0; ai < 2; ++ai)
#pragma unroll
            for (int m = 0; m < 4; ++m) { const int rl = rl0 + ai * HALF + m * 16; const f32x4 s4 = *(const LAS f32x4*)(RS + rl * 4); const float inv = 1.0f / ((s4[0] + s4[1]) + (s4[2] + s4[3]));
                bf16* rowp = P + (size_t)(row0 + ai * HALF + m * 16) * ldc + col0;
#pragma unroll
                for (int bj = 0; bj < 2; ++bj) { const f32x4 v0 = acc[ai][bj][m][0] * inv, v1 = acc[ai][bj][m][1] * inv;
                    u32x4 w; w.x = cvt_pk_bf16(v0[0], v0[1]); w.y = cvt_pk_bf16(v0[2], v0[3]); w.z = cvt_pk_bf16(v1[0], v1[1]); w.w = cvt_pk_bf16(v1[2], v1[3]);
                    *(u32x4*)(rowp + bj * HALF) = w; } }
        EPI_BAR();
    }
};

template <bool I8, int NREP = 1> struct EpiGateUp {
    static constexpr bool PERM = true;
    bf16* F; const float* rowsq; const float* cw; float* tailG; float* headG; float* headU; const unsigned* rowmaxA; const unsigned* colmaxB; LAS float* rtab;
    __device__ __forceinline__ void operator()(EPI_ARGS) const {
        LAS float* H = (LAS float*)scr;
        if (__builtin_amdgcn_readfirstlane(((LAS int*)rtab)[256]) != u.pm) { EPI_BAR();
            if (threadIdx.x < 256) { const int row = u.pm * BM + threadIdx.x; float rs = row_rstd(rowsq, row); if (I8) rs *= __uint_as_float(__hip_atomic_load(rowmaxA + row, __ATOMIC_RELAXED, __HIP_MEMORY_SCOPE_AGENT)) * (1.0f / 127.0f); rtab[threadIdx.x] = rs; }
            if (threadIdx.x == 0) ((LAS int*)rtab)[256] = u.pm; EPI_BAR(); }
        const int c8 = wc * 32 + 8 * fq, j8 = u.pn * HALF + c8;
        LAS float* ptab = (LAS float*)(scr + 5632);
        const int tcol = threadIdx.x & 127; const bool filler = threadIdx.x < 128;
        if (__builtin_amdgcn_readfirstlane(((LAS int*)ptab)[640]) != u.pn) { EPI_BAR();
            if (filler) { const int j = u.pn * HALF + tcol; ptab[tcol] = cw[j]; ptab[128 + tcol] = cw[FF + j]; ptab[256 + tcol] = cw[2 * FF + j];
                ptab[384 + tcol] = I8 ? __uint_as_float(colmaxB[u.pn * BM + tcol]) * (1.0f / 127.0f) : 1.0f; ptab[512 + tcol] = I8 ? __uint_as_float(colmaxB[u.pn * BM + HALF + tcol]) * (1.0f / 127.0f) : 1.0f; }
            if (threadIdx.x == 0) ((LAS int*)ptab)[640] = u.pn; EPI_BAR(); }
        float nxp[5] = {0.f, 0.f, 0.f, 1.f, 1.f};
        if (nx && filler) { const int j = nx->pn * HALF + tcol; nxp[0] = cw[j]; nxp[1] = cw[FF + j]; nxp[2] = cw[2 * FF + j];
            if (I8) { nxp[3] = __uint_as_float(colmaxB[nx->pn * BM + tcol]) * (1.0f / 127.0f); nxp[4] = __uint_as_float(colmaxB[nx->pn * BM + HALF + tcol]) * (1.0f / 127.0f); } }
        f32x4 w0[2], w1[2], w2[2], sb[2][2];
#pragma unroll
        for (int n = 0; n < 2; ++n) { w0[n] = *(const LAS f32x4*)(ptab + c8 + 4 * n); w1[n] = *(const LAS f32x4*)(ptab + 128 + c8 + 4 * n); w2[n] = *(const LAS f32x4*)(ptab + 256 + c8 + 4 * n);
            sb[0][n] = *(const LAS f32x4*)(ptab + 384 + c8 + 4 * n); sb[1][n] = *(const LAS f32x4*)(ptab + 512 + c8 + 4 * n); }
#pragma unroll
        for (int ai = 0; ai < 2; ++ai)
#pragma unroll
            for (int m = 0; m < 4; ++m) { const int rl = ai * HALF + wr * 64 + m * 16 + fr; const float rs = rtab[rl];
#pragma unroll
                for (int bj = 0; bj < 2; ++bj)
#pragma unroll
                    for (int n = 0; n < 2; ++n) {
                        if (I8) { const i32x4 iv = __builtin_bit_cast(i32x4, acc[ai][bj][m][n]); acc[ai][bj][m][n] = (f32x4){(float)iv[0], (float)iv[1], (float)iv[2], (float)iv[3]} * (sb[bj][n] * rs); }
                        else acc[ai][bj][m][n] = acc[ai][bj][m][n] * rs; } }
#pragma unroll
        for (int rp_ = 0; rp_ < NREP; ++rp_) {
        if (fr >= 14) {
#pragma unroll
            for (int ai = 0; ai < 2; ++ai)
#pragma unroll
                for (int n = 0; n < 2; ++n) *(LAS f32x4*)(H + (((2 * ai + wr) * 2 + (fr - 14)) * HALF + c8 + 4 * n)) = acc[ai][0][3][n];
            if (wr == 1) {
#pragma unroll
                for (int n = 0; n < 2; ++n) *(f32x4*)(tailG + ((size_t)(u.pm * 2 + (fr - 14)) * FF + j8 + 4 * n)) = acc[1][0][3][n]; }
        }
        if (wr == 0 && fr < 2) {
#pragma unroll
            for (int n = 0; n < 2; ++n) { *(f32x4*)(headG + ((size_t)(u.pm * 2 + fr) * FF + j8 + 4 * n)) = acc[0][0][0][n]; *(f32x4*)(headU + ((size_t)(u.pm * 2 + fr) * FF + j8 + 4 * n)) = acc[0][1][0][n]; } }
        EPI_BAR();
#pragma unroll
        for (int ai = 0; ai < 2; ++ai) {
            const int rb = 2 * ai + wr;
            f32x4 py1[2], py0[2];
#pragma unroll
            for (int n = 0; n < 2; ++n) { py1[n] = (f32x4){0.f, 0.f, 0.f, 0.f}; py0[n] = py1[n]; }
#pragma unroll
            for (int m = 0; m < 4; ++m) {
                f32x4 o[2];
#pragma unroll
                for (int n = 0; n < 2; ++n) {
                    const f32x4 x = acc[ai][0][m][n], up = acc[ai][1][m][n];
                    f32x4 ht = (f32x4){0.f, 0.f, 0.f, 0.f};
                    if (m == 0) { const int hb = rb > 0 ? rb - 1 : 0; const float hz = rb > 0 ? 1.f : 0.f, s0 = (fr == 0) ? hz : 0.f, s1 = (fr == 1) ? hz : 0.f;
                        const f32x4 h62 = *(const LAS f32x4*)(H + ((hb * 2 + 0) * HALF + c8 + 4 * n)), h63 = *(const LAS f32x4*)(H + ((hb * 2 + 1) * HALF + c8 + 4 * n));
#pragma unroll
                        for (int e = 0; e < 4; ++e) ht[e] = s0 * (w1[n][e] * h63[e] + w0[n][e] * h62[e]) + s1 * (w0[n][e] * h63[e]); }
                    const f32x4 y1 = x * w1[n], y0 = x * w0[n];
#pragma unroll
                    for (int e = 0; e < 4; ++e) {
                        float gg = w2[n][e] * x[e];
                        gg += dpp_shr<1>(y1[e]);
                        gg += dpp_shr<2>(y0[e]);
                        if (m > 0) { gg += dpp_shl<15>(py1[n][e]); gg += dpp_shl<14>(py0[n][e]); }
                        else gg += ht[e];
                        o[n][e] = gg * fast_sigmoid(gg) * up[e];
                    }
                    py1[n] = y1; py0[n] = y0; }
                u32x4 w; w.x = cvt_pk_bf16(o[0][0], o[0][1]); w.y = cvt_pk_bf16(o[0][2], o[0][3]); w.z = cvt_pk_bf16(o[1][0], o[1][1]); w.w = cvt_pk_bf16(o[1][2], o[1][3]);
                *(u32x4*)(F + (size_t)(u.pm * BM + ai * HALF + wr * 64 + m * 16 + fr) * FF + j8) = w;
            } }
        EPI_BAR(); }
        if (nx) { if (filler) { ptab[tcol] = nxp[0]; ptab[128 + tcol] = nxp[1]; ptab[256 + tcol] = nxp[2]; ptab[384 + tcol] = nxp[3]; ptab[512 + tcol] = nxp[4]; } if (threadIdx.x == 0) ((LAS int*)ptab)[640] = nx->pn; }
    }
};
}

constexpr size_t MiB = 1u << 20;
constexpr size_t WS_CTL = 0, CTL_ZERO_BYTES = 1 * MiB;
constexpr size_t WS_WIN = 1 * MiB;
constexpr size_t WS_XN = WS_WIN + 80 * MiB;
constexpr size_t WS_WOUT = WS_XN + 128 * MiB;
constexpr size_t WS_WKV = WS_WOUT + 32 * MiB;
constexpr size_t WS_WQ = WS_WKV + 64 * MiB;
constexpr size_t WS_WO = WS_WQ + 32 * MiB;
constexpr size_t WS_F = WS_WIN;
constexpr size_t WS_WGU = WS_WO + 32 * MiB;
constexpr size_t WS_A8 = WS_WGU + 86 * MiB;
constexpr size_t WS_WDN = WS_A8 + 64 * MiB;
constexpr size_t WS_MEMN = WS_WDN + 86 * MiB;
constexpr size_t WS_KV = WS_MEMN + 8 * MiB;
constexpr size_t WS_WQK = WS_KV + 16 * MiB;
constexpr size_t WS_VWO = WS_WQK + 32 * MiB;
constexpr size_t WS_HB = WS_VWO + 32 * MiB;
constexpr size_t WS_P = WS_HB + 128 * MiB;
constexpr size_t WS_WIN8 = WS_P + 32 * MiB;
constexpr size_t WS_XN8 = WS_WIN8 + 16 * MiB;
constexpr size_t WS_SA1 = WS_XN8 + 64 * MiB;
constexpr size_t WS_HALO = WS_SA1 + 1 * MiB;
constexpr size_t HALO_ONE = (size_t)64 * 2 * FF * 4;
constexpr size_t WS_END = WS_HALO + 18 * MiB;
static_assert(WS_F + (size_t)MTOK * FF * 2 <= WS_WGU, "F overlay");
static_assert(3 * HALO_ONE <= 18 * MiB, "halo");
constexpr int CW_BAR = 4096;
constexpr int CW_RSQ1 = 65536, CW_RSQ2 = CW_RSQ1 + MTOK, CW_RSQ3 = CW_RSQ2 + MTOK;
constexpr int CW_CMAX = CW_RSQ3 + MTOK;
constexpr int CW_RMAX = CW_CMAX + 2 * FF;
constexpr int CW_CMAX1 = CW_RMAX + MTOK;
static_assert((size_t)(CW_CMAX1 + 4096) * 4 <= CTL_ZERO_BYTES, "ctl");

constexpr int RING_OFF = 0, RING_BYTES = 131072;
constexpr int SCR_OFF = RING_BYTES;
constexpr int LDS_BYTES = 147456;
constexpr int MISC_OFF = LDS_BYTES - 128;
constexpr int NWAVES = 8;

#define XB_TMO      128
#define XB_XCNT(j)  (256  + 64 * (j))
#define XB_XSUB(j)  (1280 + 64 * (j))
#define XB_XGEN(j)  (2304 + 64 * (j))
#define XB_TOP      3328
#define XB_TOPGEN   3392
#define XCD_BAR_WORDS 3456
#define XB_SPIN_CAP (1u << 22)

__device__ __forceinline__ unsigned xb_ld(unsigned* p)              { return __hip_atomic_load(p, __ATOMIC_RELAXED, __HIP_MEMORY_SCOPE_AGENT); }
__device__ __forceinline__ unsigned xb_add(unsigned* p, unsigned v) { return __hip_atomic_fetch_add(p, v, __ATOMIC_RELAXED, __HIP_MEMORY_SCOPE_AGENT); }
__device__ __forceinline__ unsigned xb_xcc_id() { return (unsigned)__builtin_amdgcn_s_getreg((3 << 11) | 20) & 0xFu; }
#define XB_SPIN(cond, bar) do { unsigned _sp = 0; while (cond) { __builtin_amdgcn_s_sleep(1); \
    if ((++_sp & 255u) == 0u) { if (xb_ld(&(bar)[XB_TMO])) break; if (_sp > XB_SPIN_CAP) { atomicAdd(&(bar)[XB_TMO], 1u); break; } } } } while (0)

struct XcdBarrier { unsigned* bar; unsigned x; volatile LAS unsigned* st; };

__device__ __forceinline__ XcdBarrier xcd_barrier_post(unsigned* bar, volatile LAS unsigned* st) {
    XcdBarrier b; b.bar = bar; b.x = xb_xcc_id(); b.st = st;
    if (threadIdx.x == 0) (void)xb_add(&bar[XB_XCNT(b.x)], 1u);
    return b;
}
__device__ __forceinline__ void xcd_barrier_complete(unsigned* bar, unsigned x, unsigned& nloc, unsigned& nx) {
    const unsigned G = gridDim.x * gridDim.y * gridDim.z;
    unsigned sum, cnt, mine, sp = 0u;
    for (;;) {
        sum = 0u; cnt = 0u; mine = 0u;
#pragma unroll
        for (unsigned j = 0; j < 16; ++j) { const unsigned c = xb_ld(&bar[XB_XCNT(j)]); sum += c; cnt += (c > 0u) ? 1u : 0u; mine = (j == x) ? c : mine; }
        if (sum == G) break;
        __builtin_amdgcn_s_sleep(1);
        if ((++sp & 255u) == 0u) { if (xb_ld(&bar[XB_TMO])) break; if (sp > XB_SPIN_CAP) { atomicAdd(&bar[XB_TMO], 1u); break; } }
    }
    nloc = mine > 0u ? mine : 1u; nx = cnt > 0u ? cnt : 1u;
}
__device__ __forceinline__ void xcd_barrier(const XcdBarrier& b) {
    asm volatile("s_waitcnt vmcnt(0)" ::: "memory");
    __syncthreads();
    if (threadIdx.x == 0) {
        unsigned* bar = b.bar;
        __builtin_amdgcn_s_waitcnt(0);
        unsigned nloc = b.st[0], nx = b.st[1];
        if (nloc == 0u) { xcd_barrier_complete(bar, b.x, nloc, nx); b.st[0] = nloc; b.st[1] = nx; }
        const unsigned old = xb_add(&bar[XB_XSUB(b.x)], 1u);
        const unsigned gen = old / nloc;
        if (old + 1u == (gen + 1u) * nloc) {
            __builtin_amdgcn_fence(__ATOMIC_RELEASE, "agent");
            asm volatile("s_waitcnt vmcnt(0)" ::: "memory");
            const unsigned og = xb_add(&bar[XB_TOP], 1u);
            const unsigned tg = og / nx;
            if (og + 1u == (tg + 1u) * nx) xb_add(&bar[XB_TOPGEN], 1u);
            else XB_SPIN(xb_ld(&bar[XB_TOPGEN]) == tg, bar);
            __builtin_amdgcn_fence(__ATOMIC_ACQUIRE, "agent");
            xb_add(&bar[XB_XGEN(b.x)], 1u);
            asm volatile("s_waitcnt vmcnt(0)" ::: "memory");
        } else {
            XB_SPIN(xb_ld(&bar[XB_XGEN(b.x)]) == gen, bar);
            __builtin_amdgcn_fence(__ATOMIC_ACQUIRE, "agent");
            asm volatile("s_waitcnt vmcnt(0)" ::: "memory");
        }
    }
    __syncthreads();
}

#define LDS_WAIT() asm volatile("s_waitcnt lgkmcnt(0)" ::: "memory")

template <int MAP> __device__ __forceinline__ int rowmap(int n, int row_off) {
    if (MAP == 0) return row_off + n;
    if (MAP == 2) return 256 * (n >> 7) + (n & 127);
    if (MAP == 3) return 256 * (n >> 7) + 128 + (n & 127);
    const int seg = n >> 11, j = n & 2047;
    if (seg == 0) return 256 * (j >> 7) + (j & 127);
    if (seg == 1) return 256 * (j >> 7) + 128 + (j & 127);
    if (seg == 2) return 8192 + j;
    if (seg == 3) return 4096 + 256 * (j >> 7) + (j & 127);
    return 4096 + 256 * (j >> 7) + 128 + (j & 127);
}
template <int MAP> __device__ __forceinline__ void transpose_item(const float* W, int K, int N, bf16* WT, int row_off, const float* gk, LAS float* scr, int item, int lane) {
    const int nblk = N / 64, kb = item / nblk, nb = item % nblk, k0 = 64 * kb, n0 = 64 * nb;
    const int n4 = lane & 15, kr = lane >> 4;
    f32x4 v[16];
#pragma unroll
    for (int i = 0; i < 16; ++i) v[i] = *(const GAS f32x4*)(W + (size_t)(k0 + 4 * i + kr) * N + n0 + 4 * n4);
    if (gk) {
#pragma unroll
        for (int i = 0; i < 16; ++i) v[i] = v[i] * gk[k0 + 4 * i + kr]; }
#pragma unroll
    for (int i = 0; i < 16; ++i) { LAS float* d = scr + (4 * i + kr) * 65 + 4 * n4; d[0] = v[i][0]; d[1] = v[i][1]; d[2] = v[i][2]; d[3] = v[i][3]; }
    LDS_WAIT(); asm volatile("" ::: "memory");
    const int c = lane & 7, nn = lane >> 3;
#pragma unroll
    for (int j = 0; j < 8; ++j) { const int n = nn + 8 * j; const LAS float* s = scr + (8 * c) * 65 + n;
        u32x4 o; o.x = cvt_pk_bf16(s[0 * 65], s[1 * 65]); o.y = cvt_pk_bf16(s[2 * 65], s[3 * 65]); o.z = cvt_pk_bf16(s[4 * 65], s[5 * 65]); o.w = cvt_pk_bf16(s[6 * 65], s[7 * 65]);
        *(GAS u32x4*)(WT + (size_t)rowmap<MAP>(n0 + n, row_off) * K + k0 + 8 * c) = o; }
    LDS_WAIT(); asm volatile("" ::: "memory");
}
__device__ __forceinline__ unsigned pack4_i8(int a, int b, int c, int d) { return (unsigned)(a & 0xff) | ((unsigned)(b & 0xff) << 8) | ((unsigned)(c & 0xff) << 16) | ((unsigned)d << 24); }
__device__ __forceinline__ int quant_i8(float x, float inv) { return (int)fminf(fmaxf(__builtin_rintf(x * inv), -127.0f), 127.0f); }
template <int MAP> __device__ __forceinline__ void colmax_item(const float* W, int N, const float* gk, unsigned* cmax, int item, int lane) {
    const int nblk = N / 256, kb = item / nblk, nb = item % nblk, k0 = 64 * kb, n0 = 256 * nb + 4 * lane;
    f32x4 mx = (f32x4){0.f, 0.f, 0.f, 0.f};
#pragma unroll 16
    for (int k = 0; k < 64; ++k) { const f32x4 v = *(const GAS f32x4*)(W + (size_t)(k0 + k) * N + n0) * (gk ? gk[k0 + k] : 1.0f);
        mx[0] = fmaxf(mx[0], fabsf(v[0])); mx[1] = fmaxf(mx[1], fabsf(v[1])); mx[2] = fmaxf(mx[2], fabsf(v[2])); mx[3] = fmaxf(mx[3], fabsf(v[3])); }
#pragma unroll
    for (int e = 0; e < 4; ++e) __hip_atomic_fetch_max(cmax + rowmap<MAP>(n0 + e, 0), __float_as_uint(mx[e]), __ATOMIC_RELAXED, __HIP_MEMORY_SCOPE_AGENT);
}
template <int MAP> __device__ __forceinline__ void quant_item(const float* W, int K, int N, unsigned char* W8, const float* gk, const unsigned* cmax, LAS float* scr, int item, int lane) {
    const int nblk = N / 32, kb = item / nblk, nb = item % nblk, k0 = 128 * kb, n0 = 32 * nb;
    const int n4 = lane & 7, kr = lane >> 3;
    f32x4 v[16];
#pragma unroll
    for (int i = 0; i < 16; ++i) v[i] = *(const GAS f32x4*)(W + (size_t)(k0 + 8 * i + kr) * N + n0 + 4 * n4);
#pragma unroll
    for (int i = 0; i < 16; ++i) v[i] = v[i] * (gk ? gk[k0 + 8 * i + kr] : 1.0f);
#pragma unroll
    for (int i = 0; i < 16; ++i) { LAS float* d = scr + (8 * i + kr) * 33 + 4 * n4; d[0] = v[i][0]; d[1] = v[i][1]; d[2] = v[i][2]; d[3] = v[i][3]; }
    LDS_WAIT(); asm volatile("" ::: "memory");
    const int c = lane & 7, nn = lane >> 3;
#pragma unroll
    for (int j = 0; j < 4; ++j) { const int n = nn + 8 * j, dr = rowmap<MAP>(n0 + n, 0); const float cm = __uint_as_float(__hip_atomic_load(cmax + dr, __ATOMIC_RELAXED, __HIP_MEMORY_SCOPE_AGENT)); const float inv = cm > 0.f ? 127.0f / cm : 0.f;
        const LAS float* sp = scr + (16 * c) * 33 + n; int q[16];
#pragma unroll
        for (int t = 0; t < 16; ++t) q[t] = quant_i8(sp[t * 33], inv);
        u32x4 o; o.x = pack4_i8(q[0], q[1], q[2], q[3]); o.y = pack4_i8(q[4], q[5], q[6], q[7]); o.z = pack4_i8(q[8], q[9], q[10], q[11]); o.w = pack4_i8(q[12], q[13], q[14], q[15]);
        *(GAS u32x4*)(W8 + (size_t)dr * K + k0 + 16 * c) = o; }
    LDS_WAIT(); asm volatile("" ::: "memory");
}
__device__ __forceinline__ void quant_row_i8(const bf16* hrow, unsigned char* qrow, float amax, int lane) {
    const float inv = amax > 0.f ? 127.0f / amax : 0.f;
#pragma unroll
    for (int it = 0; it < 4; ++it) { const GAS u32x4* src = (const GAS u32x4*)(hrow + it * 1024 + lane * 16); const u32x4 a = src[0], b = src[1];
        u32x4 o;
        o.x = pack4_i8(quant_i8(bf_lo(a.x), inv), quant_i8(bf_hi(a.x), inv), quant_i8(bf_lo(a.y), inv), quant_i8(bf_hi(a.y), inv));
        o.y = pack4_i8(quant_i8(bf_lo(a.z), inv), quant_i8(bf_hi(a.z), inv), quant_i8(bf_lo(a.w), inv), quant_i8(bf_hi(a.w), inv));
        o.z = pack4_i8(quant_i8(bf_lo(b.x), inv), quant_i8(bf_hi(b.x), inv), quant_i8(bf_lo(b.y), inv), quant_i8(bf_hi(b.y), inv));
        o.w = pack4_i8(quant_i8(bf_lo(b.z), inv), quant_i8(bf_hi(b.z), inv), quant_i8(bf_lo(b.w), inv), quant_i8(bf_hi(b.w), inv));
        *(GAS u32x4*)(qrow + it * 1024 + lane * 16) = o; }
}
template <bool Q8> __device__ __forceinline__ void rms_rows(const float* X, const float* gain, bf16* O, unsigned char* Q, float* qs, int nrows, int m0, int mstep, int lane) {
    if (m0 >= nrows) return;
    f32x4 v[16];
#pragma unroll
    for (int j = 0; j < 16; ++j) v[j] = *((const GAS f32x4*)(X + (size_t)m0 * DM) + lane + 64 * j);
    for (int m = m0; m < nrows; m += mstep) {
        const int mn = (m + mstep < nrows) ? m + mstep : m;
        f32x4 nv[16];
#pragma unroll
        for (int j = 0; j < 16; ++j) nv[j] = *((const GAS f32x4*)(X + (size_t)mn * DM) + lane + 64 * j);
        float s = 0.f;
#pragma unroll
        for (int j = 0; j < 16; ++j) s += (v[j][0] * v[j][0] + v[j][1] * v[j][1]) + (v[j][2] * v[j][2] + v[j][3] * v[j][3]);
        const float rstd = 1.0f / sqrtf(wave_sum(s) * (1.0f / DM) + EPS);
        GAS u32x2* o8 = (GAS u32x2*)(O + (size_t)m * DM) + lane; float mx = 0.f;
#pragma unroll
        for (int j = 0; j < 16; ++j) { v[j] = v[j] * rstd * *((const GAS f32x4*)gain + lane + 64 * j); u32x2 w; w.x = cvt_pk_bf16(v[j][0], v[j][1]); w.y = cvt_pk_bf16(v[j][2], v[j][3]); o8[64 * j] = w;
            if (Q8) mx = fmaxf(mx, fmaxf(fmaxf(fabsf(v[j][0]), fabsf(v[j][1])), fmaxf(fabsf(v[j][2]), fabsf(v[j][3])))); }
        if (Q8) {
#pragma unroll
            for (int o = 1; o < 64; o <<= 1) mx = fmaxf(mx, __shfl_xor(mx, o));
            const float inv = mx > 0.f ? 127.0f / mx : 0.f;
            GAS unsigned* q4 = (GAS unsigned*)(Q + (size_t)m * DM) + lane;
#pragma unroll
            for (int j = 0; j < 16; ++j) q4[64 * j] = pack4_i8(quant_i8(v[j][0], inv), quant_i8(v[j][1], inv), quant_i8(v[j][2], inv), quant_i8(v[j][3], inv));
            if (lane == 0) qs[m] = mx * (1.0f / 127.0f);
        }
#pragma unroll
        for (int j = 0; j < 16; ++j) v[j] = nv[j];
    }
}

__device__ __forceinline__ void conv_a_wave(const bf16* U0, const float* cwp, const float* cb, const float* lg, const float* lb, bf16* MIX, LAS unsigned* T, int it0, int step, int nitems, int lane) {
    const int lr = lane >> 4, lc = lane & 15;
    int cur_grp = -1; f32x2 w[CONVK]; f32x2 bias = (f32x2){0.f, 0.f}, gg = bias, bb = bias;
#pragma unroll
    for (int k = 0; k < CONVK; ++k) w[k] = (f32x2){0.f, 0.f};
    for (int item = it0; item < nitems; item += step) {
        const int tb = item >> 4, grp = item & 15, r0 = tb * 32; const bool first = (r0 % SEQ) == 0;
        u32x4 v[16];
#pragma unroll
        for (int p = 0; p < 16; ++p) { const int rr = 4 * p + lr; v[p] = (u32x4){0u, 0u, 0u, 0u};
            if (rr < 62 && !(first && rr < 30)) v[p] = *(const GAS u32x4*)(U0 + (size_t)(r0 - 30 + rr) * CWID + grp * 128 + lc * 8); }
        if (grp != cur_grp) { cur_grp = grp;
#pragma unroll
            for (int k = 0; k < CONVK; ++k) w[k] = *(const GAS f32x2*)(cwp + k * CWID + grp * 128 + 2 * lane);
            bias = *(const GAS f32x2*)(cb + grp * 128 + 2 * lane); gg = *(const GAS f32x2*)(lg + grp * 128 + 2 * lane); bb = *(const GAS f32x2*)(lb + grp * 128 + 2 * lane); }
#pragma unroll
        for (int p = 0; p < 16; ++p) { const int rr = 4 * p + lr; if (rr < 62) *(LAS u32x4*)(T + rr * 64 + lc * 4) = v[p]; }
        LDS_WAIT(); asm volatile("" ::: "memory");
#pragma unroll
        for (int s = 0; s < 2; ++s) {
            float o0[16], o1[16];
#pragma unroll
            for (int j = 0; j < 16; ++j) { o0[j] = bias[0]; o1[j] = bias[1]; }
#pragma unroll
            for (int i = 0; i < 46; ++i) { const unsigned xw = T[(16 * s + i) * 64 + lane]; const float x0 = bf_lo(xw), x1 = bf_hi(xw);
#pragma unroll
                for (int j = 0; j < 16; ++j) { const int k = i - j; if (k >= 0 && k < CONVK) { o0[j] += w[k][0] * x0; o1[j] += w[k][1] * x1; } } }
#pragma unroll
            for (int j = 0; j < 16; ++j) {
                const float mu = wave_sum(o0[j] + o1[j]) * (1.0f / 128.0f); const float d0 = o0[j] - mu, d1 = o1[j] - mu;
                const float rstd = 1.0f / sqrtf(wave_sum(d0 * d0 + d1 * d1) * (1.0f / 128.0f) + EPS);
                const float y0 = d0 * rstd * gg[0] + bb[0], y1 = d1 * rstd * gg[1] + bb[1];
                *(GAS unsigned*)(MIX + (size_t)(r0 + 16 * s + j) * DM + grp * 128 + 2 * lane) = cvt_pk_bf16(y0 * fast_sigmoid(y0), y1 * fast_sigmoid(y1)); }
        }
        LDS_WAIT(); asm volatile("" ::: "memory");
    }
}

struct Args { const float* in[22]; float* out; unsigned char* ws; int ph_lo, ph_hi; };
constexpr int N_PHASES = 10;

__global__ void __launch_bounds__(NWAVES * 64, 2) fwd_kernel(Args args) {
    extern __shared__ __attribute__((aligned(16))) unsigned char lds_raw[];
    LAS unsigned char* lds = (LAS unsigned char*)lds_raw;
    volatile LAS unsigned* MISC = (volatile LAS unsigned*)(lds + MISC_OFF);
    const int tid = threadIdx.x, wave = __builtin_amdgcn_readfirstlane(tid >> 6);
#define lane ((int)(threadIdx.x & 63u))
    const int G = gridDim.x; const int bx = blockIdx.x; const int vcu = (G % 8 == 0) ? (bx % 8) * (G / 8) + bx / 8 : bx;
    unsigned char* ws = args.ws;
    gu32* ctl = (gu32*)(ws + WS_CTL);
    const float* x = args.in[0]; const float* mem = args.in[1]; const float* g_mix = args.in[2]; const float* w_in = args.in[3];
    const float* conv_a_w = args.in[4]; const float* conv_a_b = args.in[5]; const float* ln_a_g = args.in[6]; const float* ln_a_b = args.in[7];
    const float* conv_b_w = args.in[8]; const float* w_out = args.in[9]; const float* g_xattn = args.in[10]; const float* g_mem = args.in[11];
    const float* w_q = args.in[12]; const float* w_k = args.in[13]; const float* w_v = args.in[14]; const float* w_o = args.in[15];
    const float* g_ffn = args.in[16]; const float* w_gate = args.in[17]; const float* w_up = args.in[18]; const float* conv_f_w = args.in[19];
    const float* w_down = args.in[20]; const float* g_final = args.in[21];
    float* out = args.out;
    bf16* WIN = (bf16*)(ws + WS_WIN); bf16* XN = (bf16*)(ws + WS_XN); bf16* MIX = XN; bf16* WOUT = (bf16*)(ws + WS_WOUT); bf16* WKV = (bf16*)(ws + WS_WKV);
    bf16* WQ = (bf16*)(ws + WS_WQ); bf16* WO = (bf16*)(ws + WS_WO); bf16* FB = (bf16*)(ws + WS_F); unsigned char* WGU8 = ws + WS_WGU; unsigned char* A8 = ws + WS_A8; unsigned char* WIN8 = ws + WS_WIN8; unsigned char* XN8 = ws + WS_XN8; float* sA1 = (float*)(ws + WS_SA1); bf16* WDN = (bf16*)(ws + WS_WDN);
    bf16* MEMN = (bf16*)(ws + WS_MEMN); bf16* KV = (bf16*)(ws + WS_KV); bf16* WQK = (bf16*)(ws + WS_WQK); bf16* VWO = (bf16*)(ws + WS_VWO);
    bf16* HB = (bf16*)(ws + WS_HB); bf16* PB = (bf16*)(ws + WS_P);
    float* tailG = (float*)(ws + WS_HALO); float* headG = (float*)(ws + WS_HALO + HALO_ONE); float* headU = (float*)(ws + WS_HALO + 2 * HALO_ONE);
    unsigned* cmax1U = (unsigned*)(ws + WS_CTL) + CW_CMAX1; unsigned* cmaxU = (unsigned*)(ws + WS_CTL) + CW_CMAX; unsigned* rmaxU = (unsigned*)(ws + WS_CTL) + CW_RMAX;
    float* rsq1 = (float*)(ws + WS_CTL) + CW_RSQ1; float* rsq2 = (float*)(ws + WS_CTL) + CW_RSQ2; float* rsq3 = (float*)(ws + WS_CTL) + CW_RSQ3;
    bf16* U0 = (bf16*)out; bf16* CH = U0 + (size_t)MTOK * CWID; bf16* BG = CH + (size_t)MTOK * CWID;

    if (tid < 32) MISC[tid] = 0u;
    __syncthreads();
    XcdBarrier bar; bar.bar = (unsigned*)(ctl + CW_BAR); bar.x = 0; bar.st = nullptr;
    if (MK_N_LAUNCHES == 1) bar = xcd_barrier_post((unsigned*)(ctl + CW_BAR), MISC + 8);
    const int lo = args.ph_lo, hi = args.ph_hi;
#define IN(k) (lo <= (k) && (k) < hi)
#define BOTH(k) (IN(k) && IN((k) + 1))
#define GRID_BAR() xcd_barrier(bar)
#define REPS(k) _Pragma("unroll") for (int rep_ = 0; rep_ <= ((DUP_MASK >> (k)) & 1); ++rep_)
    float* dummy_out = (float*)(ws + WS_END); float* dummy_rsq = (float*)(ws + WS_END + (size_t)MTOK * DM * 4);
    LAS unsigned char* ring = lds + RING_OFF; LAS unsigned char* scr = lds + SCR_OFF;
    const int gw = vcu * NWAVES + wave, NGW = G * NWAVES;

    if (IN(0)) { REPS(0) {
        LAS float* tscr = (LAS float*)(lds + wave * 16640);
        constexpr int I_IN = (DM / 64) * ((INW - 2 * CWID) / 64), I_SQ = (DM / 64) * (DM / 64), I_FF = (DM / 64) * (FF / 64), I_DN = (FF / 64) * (DM / 64);
        constexpr int NITEMS = I_IN + 2 * I_SQ; (void)I_FF; (void)I_DN;
        _Pragma("nounroll") for (int r11_ = 0; r11_ <= ((DUP_MASK >> 11) & 1); ++r11_)
        for (int it = gw; it < NITEMS; it += NGW) {
            int r = it;
            if (r < I_IN) { transpose_item<1>(w_in, DM, INW, WIN, 0, nullptr, tscr, (r / 96) * (INW / 64) + 64 + (r % 96), lane); continue; } r -= I_IN;
            if (r < I_SQ) { transpose_item<0>(w_k, DM, DM, WKV, 0, nullptr, tscr, r, lane); continue; } r -= I_SQ;
            transpose_item<0>(w_v, DM, DM, WKV, DM, nullptr, tscr, r, lane);
        }
        _Pragma("nounroll") for (int r12_ = 0; r12_ <= ((DUP_MASK >> 12) & 1); ++r12_)
        { constexpr int I_CM = (DM / 64) * (FF / 256);
          for (int it = gw; it < 2 * I_CM; it += NGW) { if (it < I_CM) colmax_item<2>(w_gate, FF, g_ffn, cmaxU, it, lane); else colmax_item<3>(w_up, FF, g_ffn, cmaxU, it - I_CM, lane); }
          for (int it = gw; it < (DM / 64) * 16; it += NGW) colmax_item<1>(w_in, INW, nullptr, cmax1U, (it / 16) * (INW / 256) + (it % 16), lane); }
        _Pragma("nounroll") for (int r13_ = 0; r13_ <= ((DUP_MASK >> 13) & 1); ++r13_)
        rms_rows<true>(x, g_mix, XN, XN8, sA1, MTOK, gw, NGW, lane);
        rms_rows<false>(mem, g_mem, MEMN, nullptr, nullptr, MMEM, gw, NGW, lane);
        __syncthreads(); }
        if (BOTH(0)) GRID_BAR();
    }

    if (IN(1)) {
        { pg8::Gemm g{MEMN, WKV, DM, DM, DM, 1, 1 << 30, 0, 0, 0, 0, 0}; pg8::BatchOrder S; S.init(MMEM / 256, 2 * DM / 256, 1, G, vcu);
          pg8::EpiBf16 E{KV, 2 * DM, nullptr, 1.0f, 1, 0, 0};
          pg8::gemm_phase(ring, scr, g, S, E); }
        { constexpr int NKV = (MMEM / 256) * (2 * DM / 256);
          const bool all = G <= NKV; if (all || vcu >= NKV) { const int cw_ = all ? gw : (vcu - NKV) * NWAVES + wave, ncw = all ? NGW : (G - NKV) * NWAVES;
            { LAS float* qscr = (LAS float*)(lds + wave * 16896); constexpr int I_Q1 = (DM / 128) * (2 * CWID / 32);
              for (int it = cw_; it < I_Q1; it += ncw) quant_item<1>(w_in, DM, INW, WIN8, nullptr, cmax1U, qscr, (it / 128) * (INW / 32) + (it % 128), lane); }
            __syncthreads();
            LAS float* tscr = (LAS float*)(lds + wave * 16640); constexpr int I_SQ = (DM / 64) * (DM / 64);
            for (int it = cw_; it < 2 * I_SQ; it += ncw) { if (it < I_SQ) transpose_item<0>(w_out, DM, DM, WOUT, 0, nullptr, tscr, it, lane); else transpose_item<0>(w_o, DM, DM, WO, 0, nullptr, tscr, it - I_SQ, lane); }
            for (size_t i = (size_t)(cw_ >> 3) * 512 + tid; i < (size_t)DM * DM / 8; i += (size_t)(ncw >> 3) * 512) {
                const f32x4 a = *((const GAS f32x4*)w_q + 2 * i), b = *((const GAS f32x4*)w_q + 2 * i + 1);
                u32x4 w; w.x = cvt_pk_bf16(a[0], a[1]); w.y = cvt_pk_bf16(a[2], a[3]); w.z = cvt_pk_bf16(b[0], b[1]); w.w = cvt_pk_bf16(b[2], b[3]);
                *((GAS u32x4*)WQ + i) = w; } } }
        GRID_BAR();
        REPS(1) {
        { pg8::Gemm g{(const bf16*)XN8, (const bf16*)WIN8, DM / 2, DM / 2, DM / 2, 1, 1 << 30, 0, 0, 0, 0, 0}; pg8::StaticOrder S; S.init(MTOK / 256, 2 * CWID / 256, G, bx);
          LAS float* rtab = (LAS float*)(scr + 4096); if (tid == 0) ((LAS int*)rtab)[256] = -1; __syncthreads();
          pg8::EpiProj<true> E{U0, CH, BG, 0, sA1, cmax1U, rtab};
          pg8::gemm_phase<true>(ring, scr, g, S, E); }
        { pg8::Gemm g{XN, WIN + (size_t)2 * CWID * DM, DM, DM, DM, 1, 1 << 30, 0, 0, 0, 0, 0}; pg8::StaticOrder S; S.init(MTOK / 256, (INW - 2 * CWID) / 256, G, bx);
          pg8::EpiProj<false> E{U0, CH, BG, 2 * CWID / 256, nullptr, nullptr, nullptr};
          pg8::gemm_phase(ring, scr, g, S, E); } }
        if (BOTH(1)) GRID_BAR();
    }

    if (IN(2)) {
        _Pragma("nounroll") for (int rep2_ = 0; rep2_ <= ((DUP_MASK >> 2) & 1); ++rep2_) {
        { LAS unsigned* T = (LAS unsigned*)(lds + wave * 15872);
          conv_a_wave(U0, conv_a_w, conv_a_b, ln_a_g, ln_a_b, MIX, T, gw, NGW, (MTOK / 32) * 16, lane); }
        for (size_t i = (size_t)vcu * 512 + tid; i < (size_t)(MTOK / 4) * (CWID / 8); i += (size_t)G * 512) {
            const int rq = (int)(i >> 8), ch = (int)(i & 255), row0 = rq * 4; const bool first = (row0 % SEQ) == 0;
            const u32x4 z4 = (u32x4){0u, 0u, 0u, 0u};
            u32x4 cv[6], bg[4];
#pragma unroll
            for (int r = 0; r < 6; ++r) cv[r] = (first && r < 2) ? z4 : *(const GAS u32x4*)(CH + (size_t)(row0 - 2 + r) * CWID + ch * 8);
#pragma unroll
            for (int r = 0; r < 4; ++r) bg[r] = *(const GAS u32x4*)(BG + (size_t)(row0 + r) * CWID + ch * 8);
            float w0[8], w1[8], w2[8];
#pragma unroll
            for (int h = 0; h < 2; ++h) { const f32x4 a = *(const GAS f32x4*)(conv_b_w + ch * 8 + 4 * h), b = *(const GAS f32x4*)(conv_b_w + CWID + ch * 8 + 4 * h), c = *(const GAS f32x4*)(conv_b_w + 2 * CWID + ch * 8 + 4 * h);
#pragma unroll
                for (int e = 0; e < 4; ++e) { w0[4 * h + e] = a[e]; w1[4 * h + e] = b[e]; w2[4 * h + e] = c[e]; } }
#pragma unroll
            for (int r = 0; r < 4; ++r) { unsigned ow[4];
#pragma unroll
                for (int p_ = 0; p_ < 4; ++p_) {
                    const float lo_ = bf_lo(bg[r][p_]) * (w0[2 * p_] * bf_lo(cv[r][p_]) + w1[2 * p_] * bf_lo(cv[r + 1][p_]) + w2[2 * p_] * bf_lo(cv[r + 2][p_]));
                    const float hi_ = bf_hi(bg[r][p_]) * (w0[2 * p_ + 1] * bf_hi(cv[r][p_]) + w1[2 * p_ + 1] * bf_hi(cv[r + 1][p_]) + w2[2 * p_ + 1] * bf_hi(cv[r + 2][p_]));
                    ow[p_] = cvt_pk_bf16(lo_, hi_); }
                *(GAS u32x4*)(MIX + (size_t)(row0 + r) * DM + CWID + ch * 8) = (u32x4){ow[0], ow[1], ow[2], ow[3]}; }
        }
        __syncthreads(); }
        REPS(10) {
        { pg8::Gemm g{KV, WQ, 2 * DM, DM, HDIM, 4, 1 << 30, (size_t)MEMLEN * 2 * DM, (size_t)HDIM, 0, (size_t)HDIM, 0}; pg8::BatchOrder S; S.init(1, DM / 256, 16, G, vcu);
          pg8::EpiBf16 E{WQK, DM, g_xattn, 0.03125f * LOG2E, 16, 0, (size_t)MEMLEN * DM};
          pg8::gemm_phase(ring, scr, g, S, E); }
        { pg8::Gemm g{WO, KV + DM, DM, 2 * DM, HDIM, 4, 1 << 30, 0, (size_t)HDIM, (size_t)MEMLEN * 2 * DM, (size_t)HDIM, 0}; pg8::BatchOrder S; S.init(DM / 256, 1, 16, G, vcu);
          pg8::EpiBf16 E{VWO, NHEAD * MEMLEN, nullptr, 1.0f, 4, (size_t)DM * NHEAD * MEMLEN, (size_t)MEMLEN};
          pg8::gemm_phase(ring, scr, g, S, E); } }
        if (BOTH(2)) GRID_BAR();
    }

    if (IN(3)) {
        pg8::Gemm g{MIX, WOUT, DM, DM, DM, 1, 1 << 30, 0, 0, 0, 0, 0}; pg8::StaticOrder S; S.init(MTOK / 256, DM / 256, G, bx);
        constexpr int I_Q8 = (DM / 128) * (FF / 32); const int hq = G >> 1;
        if ((bx & 1) && hq > 0) { LAS float* qscr = (LAS float*)(lds + wave * 16896);
            for (int it = (bx >> 1) * NWAVES + wave; it < I_Q8; it += hq * NWAVES) quant_item<2>(w_gate, DM, FF, WGU8, g_ffn, cmaxU, qscr, it, lane);
            __syncthreads(); }
        REPS(3) { pg8::EpiResid<false> E{x, HB, rep_ ? dummy_rsq : rsq1, nullptr, DM};
        pg8::gemm_phase(ring, scr, g, S, E); }
        if (!(bx & 1) || hq == 0) { LAS float* qscr = (LAS float*)(lds + wave * 16896); const int nq = hq > 0 ? (G - hq) : G, iq = hq > 0 ? (bx >> 1) : bx;
            for (int it = iq * NWAVES + wave; it < I_Q8; it += nq * NWAVES) quant_item<3>(w_up, DM, FF, WGU8, g_ffn, cmaxU, qscr, it, lane);
            if (hq == 0) for (int it = iq * NWAVES + wave; it < I_Q8; it += nq * NWAVES) quant_item<2>(w_gate, DM, FF, WGU8, g_ffn, cmaxU, qscr, it, lane); }
        if (BOTH(3)) GRID_BAR();
    }

    if (IN(4)) {
        pg8::Gemm g{HB, WQK, DM, DM, DM, 1, SEQ / 256, 0, 0, 0, 0, (size_t)NHEAD * MEMLEN * DM}; pg8::StaticOrder S; S.init(MTOK / 256, NHEAD, G, bx);
        pg8::EpiSoftmax E{PB, rsq1, NHEAD * MEMLEN};
        REPS(4) pg8::gemm_phase(ring, scr, g, S, E);
        if (BOTH(4)) GRID_BAR();
    }

    if (IN(5)) {
        pg8::Gemm g{PB, VWO, NHEAD * MEMLEN, NHEAD * MEMLEN, NHEAD * MEMLEN, 1, SEQ / 256, 0, 0, 0, 0, (size_t)DM * NHEAD * MEMLEN}; pg8::StaticOrder S; S.init(MTOK / 256, DM / 256, G, bx);
        REPS(5) { pg8::EpiResid<true> E{HB, rep_ ? (bf16*)dummy_out : HB, rep_ ? dummy_rsq : rsq2, rep_ ? (unsigned*)nullptr : rmaxU, DM};
        pg8::gemm_phase(ring, scr, g, S, E); }
        GRID_BAR();
        for (int m = gw; m < MTOK; m += NGW) quant_row_i8(HB + (size_t)m * DM, A8 + (size_t)m * DM, __uint_as_float(__hip_atomic_load(rmaxU + m, __ATOMIC_RELAXED, __HIP_MEMORY_SCOPE_AGENT)), lane);
        if (BOTH(5)) GRID_BAR();
    }

    if (IN(6)) {
        pg8::Gemm g{(const bf16*)A8, (const bf16*)WGU8, DM / 2, DM / 2, DM / 2, 1, 1 << 30, 0, 0, 0, 0, 0}; pg8::StaticOrder S; S.init(MTOK / 256, 2 * FF / 256, G, bx);
        LAS float* rtab = (LAS float*)(scr + 4096); if (tid == 0) { ((LAS int*)rtab)[256] = -1; ((LAS int*)(scr + 5632))[640] = -1; } __syncthreads();
        pg8::EpiGateUp<true, 1 + ((DUP_MASK >> 17) & 1)> E{FB, rsq2, conv_f_w, tailG, headG, headU, rmaxU, cmaxU, rtab};
        REPS(6) pg8::gemm_phase<true>(ring, scr, g, S, E);
    }
    if (IN(6)) {
        constexpr int NU = (2 * FF / 256) * (MTOK / 256); const int last = NU / G, used = NU - last * G, nfree = G - used, myidx = bx - used;
        if (myidx >= 0) { LAS float* tscr = (LAS float*)(lds + wave * 16640); constexpr int I_DN = (FF / 64) * (DM / 64);
            for (int it = myidx * NWAVES + wave; it < I_DN; it += nfree * NWAVES) transpose_item<0>(w_down, FF, DM, WDN, 0, nullptr, tscr, it, lane); }
        if (BOTH(6)) GRID_BAR();
    }

    if (IN(7)) {
        for (size_t i = (size_t)vcu * 512 + tid; i < (size_t)64 * FF; i += (size_t)G * 512) {
            const int pm = (int)(i / FF), j = (int)(i % FF);
            if ((pm & 15) == 0) continue;
            const float t0 = tailG[(size_t)((pm - 1) * 2 + 0) * FF + j], t1 = tailG[(size_t)((pm - 1) * 2 + 1) * FF + j];
            const float g0 = headG[(size_t)(pm * 2 + 0) * FF + j], g1 = headG[(size_t)(pm * 2 + 1) * FF + j];
            const float u0 = headU[(size_t)(pm * 2 + 0) * FF + j], u1 = headU[(size_t)(pm * 2 + 1) * FF + j];
            const float c0 = conv_f_w[j], c1 = conv_f_w[FF + j], c2 = conv_f_w[2 * FF + j];
            const float a0 = c2 * g0 + c1 * t1 + c0 * t0, a1 = c2 * g1 + c1 * g0 + c0 * t1;
            const unsigned p0 = cvt_pk_bf16(a0 * fast_sigmoid(a0) * u0, 0.f), p1 = cvt_pk_bf16(a1 * fast_sigmoid(a1) * u1, 0.f);
            FB[(size_t)(pm * 256 + 0) * FF + j] = (bf16)(p0 & 0xffffu); FB[(size_t)(pm * 256 + 1) * FF + j] = (bf16)(p1 & 0xffffu);
        }
        if (BOTH(7)) GRID_BAR();
    }

    if (IN(8)) {
        pg8::Gemm g{FB, WDN, FF, FF, FF, 1, 1 << 30, 0, 0, 0, 0, 0}; pg8::BatchOrder S; S.init(MTOK / 256, DM / 256, 1, G, vcu);
        { pg8::EpiResid<true> E{HB, HB, rsq3, nullptr, DM}; pg8::gemm_phase(ring, scr, g, S, E); }
        if ((DUP_MASK >> 8) & 1) { pg8::EpiResid<true> E{HB, (bf16*)dummy_out, dummy_rsq, nullptr, DM}; pg8::gemm_phase<false, DUP_VAR>(ring, scr, g, S, E); }
        if (BOTH(8)) GRID_BAR();
    }

    if (IN(9)) {
        if ((DUP_MASK >> 14) & 1) { _Pragma("nounroll") for (int r14_ = 0; r14_ < 8; ++r14_) GRID_BAR(); }
        const bool bad = (MK_N_LAUNCHES == 1) && (__hip_atomic_load(ctl + CW_BAR + XB_TMO, __ATOMIC_RELAXED, __HIP_MEMORY_SCOPE_AGENT) != 0u);
        REPS(9) { const bool dup_ = rep_ < ((DUP_MASK >> 9) & 1);
        f32x4 gv[16];
#pragma unroll
        for (int j = 0; j < 16; ++j) gv[j] = *((const GAS f32x4*)g_final + lane + 64 * j);
        for (int m = gw; m < MTOK; m += 2 * NGW) {
            const int mb = (m + NGW < MTOK) ? m + NGW : m;
            const float ra = bad ? __builtin_nanf("") : pg8::row_rstd(rsq3, m), rb = bad ? __builtin_nanf("") : pg8::row_rstd(rsq3, mb);
            u32x2 ha[16], hb[16];
#pragma unroll
            for (int j = 0; j < 16; ++j) { ha[j] = *((const GAS u32x2*)(HB + (size_t)m * DM) + lane + 64 * j); hb[j] = *((const GAS u32x2*)(HB + (size_t)mb * DM) + lane + 64 * j); }
            GAS f32x4* wa = (GAS f32x4*)((dup_ ? dummy_out : out) + (size_t)m * DM) + lane; GAS f32x4* wb = (GAS f32x4*)((dup_ ? dummy_out : out) + (size_t)mb * DM) + lane;
#pragma unroll
            for (int j = 0; j < 16; ++j) wa[64 * j] = (f32x4){bf_lo(ha[j].x), bf_hi(ha[j].x), bf_lo(ha[j].y), bf_hi(ha[j].y)} * ra * gv[j];
            if (mb != m) {
#pragma unroll
                for (int j = 0; j < 16; ++j) wb[64 * j] = (f32x4){bf_lo(hb[j].x), bf_hi(hb[j].x), bf_lo(hb[j].y), bf_hi(hb[j].y)} * rb * gv[j]; }
        } }
    }
#undef IN
#undef BOTH
#undef GRID_BAR
#undef lane
}

extern "C" void kernel_launch(void* const* d_in, const int* in_sizes, int n_in, void* d_out, int out_size, void* d_ws, size_t ws_size, hipStream_t stream) {
    static int grid = 0;
    if (grid == 0) {
        if (n_in != 22 || in_sizes[0] != MTOK * DM || out_size != MTOK * DM || ws_size < WS_END + (DUP_MASK ? (size_t)257 * MiB : 0)) { fprintf(stderr, "kernel_launch: unexpected shapes (n_in %d, in0 %d, out %d, ws %zu < %zu)\n", n_in, n_in > 0 ? in_sizes[0] : -1, out_size, ws_size, (size_t)WS_END); grid = -1; return; }
        int dev = 0, cus = 0, per_cu = 0;
        if (hipGetDevice(&dev) != hipSuccess || hipDeviceGetAttribute(&cus, hipDeviceAttributeMultiprocessorCount, dev) != hipSuccess) { grid = -1; return; }
        if (hipFuncSetAttribute((const void*)fwd_kernel, hipFuncAttributeMaxDynamicSharedMemorySize, LDS_BYTES) != hipSuccess) { fprintf(stderr, "kernel_launch: hipFuncSetAttribute failed\n"); grid = -1; return; }
        if (hipOccupancyMaxActiveBlocksPerMultiprocessor(&per_cu, (const void*)fwd_kernel, NWAVES * 64, LDS_BYTES) != hipSuccess || per_cu < 1) { fprintf(stderr, "kernel_launch: occupancy query says %d\n", per_cu); }
        (void)hipGetLastError();
        grid = cus;
    }
    if (grid < 0) return;
    if (hipMemsetAsync((char*)d_ws + WS_CTL, 0, CTL_ZERO_BYTES, stream) != hipSuccess) return;
    Args a{};
    for (int i = 0; i < 22; ++i) a.in[i] = (const float*)d_in[i];
    a.out = (float*)d_out; a.ws = (unsigned char*)d_ws;
    if (MK_N_LAUNCHES == 1) {
        a.ph_lo = 0; a.ph_hi = N_PHASES;
        hipLaunchKernelGGL(fwd_kernel, dim3(grid), dim3(NWAVES * 64), LDS_BYTES, stream, a);
    } else {
        for (int p = 0; p < N_PHASES; ++p) { a.ph_lo = p; a.ph_hi = p + 1; hipLaunchKernelGGL(fwd_kernel, dim3(grid), dim3(NWAVES * 64), LDS_BYTES, stream, a); }
    }
}
```
